# Optimizing an MI355X kernel written in HIP

```python
import jax, jax.numpy as jnp
from jax import lax
import numpy as np

D_MODEL = 1024
BATCH = 8
SEQ = 2048
DEPTH = 4
DEC_BATCH = 128
DEC_SEQ = 1
PAST_LEN = 16384
PAGE_SIZE = 128

A_HEADS = 4
A_DK = 128
A_DV = 128
A_WIDTH = A_HEADS * A_DK
A_VW = A_HEADS * A_DV
A_CHUNK = 64
B_WIDTH = D_MODEL // 4
B_GROUPS = 4
B_GDIM = B_WIDTH // B_GROUPS
POOL_WINDOWS = (2, 4, 8, 16)
POOL_STATE = max(POOL_WINDOWS) - 1
C_WIDTH = D_MODEL // 4
C_GROUPS = 4
C_GDIM = C_WIDTH // C_GROUPS
C_CHUNK = 128
N_BRANCH = 3
IN_SPLITS = tuple(np.cumsum([A_WIDTH, A_WIDTH, A_VW, A_VW, B_WIDTH, C_WIDTH, C_WIDTH]).tolist())
IN_COLS = 2 * A_WIDTH + 2 * A_VW + B_WIDTH + 2 * C_WIDTH + N_BRANCH * D_MODEL
D_FF = -(-8 * D_MODEL // (3 * 256)) * 256
EPS = 1e-6
LB_FLOOR = 1e-30

kernel_name = "hybrid_hgrn2_pool_gmlp_decode_step"


def rmsnorm(x):
    xf = x.astype(jnp.float32)
    return (xf * lax.rsqrt(jnp.mean(xf * xf, -1, keepdims=True) + EPS)).astype(x.dtype)


def layernorm(x, g, b):
    xf = x.astype(jnp.float32)
    mu = jnp.mean(xf, -1, keepdims=True)
    var = jnp.mean(jnp.square(xf - mu), -1, keepdims=True)
    return ((xf - mu) * lax.rsqrt(var + EPS)).astype(x.dtype) * g + b


def hgrn2_recurrence(q, log_f, k, v, s0):
    B, L, H = q.shape[:3]
    cl = min(A_CHUNK, L)
    n = -(-L // cl)
    pad = n * cl - L

    def prep(a):
        a = jnp.pad(a.astype(jnp.float32), ((0, 0), (0, pad), (0, 0), (0, 0)))
        return a.reshape(B, n, cl, H, a.shape[-1]).transpose(1, 0, 3, 2, 4)

    qc, gc, kc, vc = prep(q), prep(log_f), prep(k), prep(v)
    causal = jnp.tril(jnp.ones((cl, cl), bool))[:, :, None]

    def step(s, inp):
        qb, gb, kb, vb = inp
        b = jnp.cumsum(gb, axis=2)
        diff = b[:, :, :, None, :] - b[:, :, None, :, :]
        decay = jnp.where(causal, jnp.exp(jnp.where(causal, diff, 0.0)), 0.0)
        scores = jnp.einsum('bhtk,bhtsk,bhsk->bhts', qb, decay, kb)
        o = (jnp.einsum('bhts,bhsv->bhtv', scores, vb)
             + jnp.einsum('bhtk,bhkv->bhtv', qb * jnp.exp(b), s))
        b_last = b[:, :, -1:, :]
        s_new = (jnp.exp(b_last[:, :, 0, :])[..., None] * s
                 + jnp.einsum('bhsk,bhsv->bhkv', kb * jnp.exp(b_last - b), vb))
        return s_new, o

    s_fin, o = lax.scan(step, s0.astype(jnp.float32), (qc, gc, kc, vc))
    o = o.transpose(1, 0, 3, 2, 4).reshape(B, n * cl, H, vc.shape[-1])[:, :L]
    return o, s_fin


def pool_mixer(p, prefix, n_valid, w_map, scale):
    Bn, L = p.shape[:2]
    xp = jnp.concatenate([prefix.astype(p.dtype), p], 1)
    xf = xp.astype(jnp.float32)
    cs = jnp.pad(jnp.cumsum(xf, 1), ((0, 0), (1, 0), (0, 0)))
    j = jnp.arange(L)
    end = cs[:, POOL_STATE + 1:]
    means = []
    for g, w in enumerate(POOL_WINDOWS):
        sl = slice(g * B_GDIM, (g + 1) * B_GDIM)
        start = cs[:, POOL_STATE + 1 - w: POOL_STATE + 1 - w + L, sl]
        cnt = jnp.minimum(j + 1 + n_valid, w).astype(jnp.float32)[None, :, None]
        means.append((end[..., sl] - start) / cnt)
    z = (jnp.concatenate(means, -1) - xf[:, POOL_STATE:]).astype(p.dtype)
    z = jnp.einsum('blgc,gcd->blgd', z.reshape(Bn, L, B_GROUPS, B_GDIM), w_map)
    return z.reshape(Bn, L, B_WIDTH) * scale, xp[:, -POOL_STATE:]


def chunk_spatial_gating(u, v, ln_g, ln_b, w_s, b_s):
    Bn, L = u.shape[:2]
    vn = layernorm(v, ln_g, ln_b)
    cl = min(C_CHUNK, L)
    n = -(-L // cl)
    pad = n * cl - L
    vp = jnp.pad(vn, ((0, 0), (0, pad), (0, 0))).reshape(Bn, n, cl, C_GROUPS, C_GDIM)
    w = jnp.where(jnp.tril(jnp.ones((cl, cl), bool)), w_s[:, :cl, :cl], 0.0)
    s = jnp.einsum('gts,bnsgc->bntgc', w, vp) + b_s[:, :cl].T[None, None, :, :, None]
    s = s.reshape(Bn, n * cl, C_WIDTH)[:, :L]
    return u * s, vn


def trunk(x, c, st_hgrn, st_pool, n_valid, keep_chunk_rows, w_ada, b_ada, w_in, lb_logits, a_norm_g,
          pool_map, pool_scale, c_ln_g, c_ln_b, c_ws, c_bs, w_br_a, w_br_b, w_br_c, w_out,
          w_ffn_in, w_ffn_out, final_g):
    Bn, L, _ = x.shape
    p_lb = jax.nn.softmax(lb_logits.astype(jnp.float32), axis=0)
    lower_bounds = jnp.maximum(jnp.cumsum(p_lb, axis=0) - p_lb[0:1], 0.0)
    cond = jax.nn.silu(c)
    new_h, new_p, new_v = [], [], []
    for l in range(DEPTH):
        mod = (cond @ w_ada[l] + b_ada[l])[:, None, :]
        sh1, sc1, g1, sh2, sc2, g2 = jnp.split(mod, 6, axis=-1)
        h = rmsnorm(x) * (1 + sc1) + sh1
        z = h @ w_in[l]
        q, f_pre, i_a, g_a, p_b, u_c, v_c, gates = jnp.split(z, IN_SPLITS, axis=-1)
        lb = lower_bounds[l]
        f32 = f_pre.astype(jnp.float32)
        log_f = jnp.logaddexp(jnp.log(lb + LB_FLOOR), jnp.log1p(-lb) + jax.nn.log_sigmoid(f32))
        k = (1 - lb) * jax.nn.sigmoid(-f32)
        o, s_fin = hgrn2_recurrence(
            jax.nn.silu(q).reshape(Bn, L, A_HEADS, A_DK), log_f.reshape(Bn, L, A_HEADS, A_DK),
            k.reshape(Bn, L, A_HEADS, A_DK), i_a.reshape(Bn, L, A_HEADS, A_DV), st_hgrn[l])
        o = rmsnorm(o.astype(x.dtype)) * a_norm_g[l] * jax.nn.silu(g_a.reshape(Bn, L, A_HEADS, A_DV))
        y_a = o.reshape(Bn, L, A_VW) @ w_br_a[l]
        pb, pool_rows = pool_mixer(p_b, st_pool[l], n_valid, pool_map[l], pool_scale[l])
        y_b = pb @ w_br_b[l]
        gm, vn = chunk_spatial_gating(jax.nn.gelu(u_c), jax.nn.gelu(v_c), c_ln_g[l], c_ln_b[l], c_ws[l], c_bs[l])
        y_c = gm @ w_br_c[l]
        ga, gb, gc = jnp.split(jax.nn.sigmoid(gates), N_BRANCH, axis=-1)
        m = ga * y_a + gb * y_b + gc * y_c
        x = x + g1 * (m @ w_out[l])
        h2 = rmsnorm(x) * (1 + sc2) + sh2
        gt, up = jnp.split(h2 @ w_ffn_in[l], 2, axis=-1)
        x = x + g2 * ((jax.nn.silu(gt) * up) @ w_ffn_out[l])
        new_h.append(s_fin.astype(x.dtype))
        new_p.append(pool_rows)
        if keep_chunk_rows:
            new_v.append(vn)
    y = rmsnorm(x) * final_g
    v_rows = jnp.stack(new_v) if keep_chunk_rows else None
    return y, jnp.stack(new_h), jnp.stack(new_p), v_rows


def setup_inputs(seed: int = 0) -> dict:
    key = jax.random.key(seed)
    ks = jax.random.split(key, 32)
    nrm = lambda k, shape, s: jax.random.normal(k, shape, jnp.float32) * s
    return {
        'x_prompt': nrm(ks[0], (BATCH, SEQ, D_MODEL), 1.0),
        'x_sample': nrm(ks[1], (DEC_BATCH, DEC_SEQ, D_MODEL), 1.0),
        'state_hgrn': nrm(ks[2], (DEPTH, DEC_BATCH, A_HEADS, A_DK, A_DV), 0.5),
        'state_pool': nrm(ks[3], (DEPTH, DEC_BATCH, POOL_STATE, B_WIDTH), 1.0),
        'c_prompt': nrm(ks[4], (BATCH, D_MODEL), 1.0),
        'c_sample': nrm(ks[5], (DEC_BATCH, D_MODEL), 1.0),
        'w_ada': nrm(ks[6], (DEPTH, D_MODEL, 6 * D_MODEL), 0.5 * D_MODEL ** -0.5),
        'b_ada': nrm(ks[7], (DEPTH, 6 * D_MODEL), 0.02),
        'w_in': nrm(ks[8], (DEPTH, D_MODEL, IN_COLS), D_MODEL ** -0.5),
        'lb_logits': nrm(ks[9], (DEPTH, A_WIDTH), 1.0),
        'a_norm_g': 1.0 + nrm(ks[10], (DEPTH, A_HEADS, A_DV), 0.05),
        'pool_map': nrm(ks[11], (DEPTH, B_GROUPS, B_GDIM, B_GDIM), B_GDIM ** -0.5),
        'pool_scale': 1.0 + nrm(ks[12], (DEPTH, B_WIDTH), 0.05),
        'c_ln_g': 1.0 + nrm(ks[13], (DEPTH, C_WIDTH), 0.05),
        'c_ln_b': nrm(ks[14], (DEPTH, C_WIDTH), 0.02),
        'c_ws': nrm(ks[15], (DEPTH, C_GROUPS, C_CHUNK, C_CHUNK), C_CHUNK ** -0.5),
        'c_bs': 1.0 + nrm(ks[16], (DEPTH, C_GROUPS, C_CHUNK), 0.1),
        'w_br_a': nrm(ks[17], (DEPTH, A_VW, D_MODEL), A_VW ** -0.5),
        'w_br_b': nrm(ks[18], (DEPTH, B_WIDTH, D_MODEL), B_WIDTH ** -0.5),
        'w_br_c': nrm(ks[19], (DEPTH, C_WIDTH, D_MODEL), C_WIDTH ** -0.5),
        'w_out': nrm(ks[20], (DEPTH, D_MODEL, D_MODEL), D_MODEL ** -0.5),
        'w_ffn_in': nrm(ks[21], (DEPTH, D_MODEL, 2 * D_FF), D_MODEL ** -0.5),
        'w_ffn_out': nrm(ks[22], (DEPTH, D_FF, D_MODEL), D_FF ** -0.5),
        'final_g': 1.0 + nrm(ks[23], (D_MODEL,), 0.05),
    }


def reference(x_prompt, x_sample, state_hgrn, state_pool, c_prompt, c_sample, w_ada, b_ada, w_in,
              lb_logits, a_norm_g, pool_map, pool_scale, c_ln_g, c_ln_b, c_ws, c_bs, w_br_a, w_br_b,
              w_br_c, w_out, w_ffn_in, w_ffn_out, final_g):
    weights = (w_ada, b_ada, w_in, lb_logits, a_norm_g, pool_map, pool_scale, c_ln_g, c_ln_b, c_ws, c_bs,
               w_br_a, w_br_b, w_br_c, w_out, w_ffn_in, w_ffn_out, final_g)
    Bp = x_prompt.shape[0]
    h0 = jnp.zeros((DEPTH, Bp, A_HEADS, A_DK, A_DV), x_prompt.dtype)
    p0 = jnp.zeros((DEPTH, Bp, POOL_STATE, B_WIDTH), x_prompt.dtype)
    y_prompt, hgrn_prompt, pool_prompt, _ = trunk(x_prompt, c_prompt, h0, p0, 0, False, *weights)
    y_sample, hgrn_sample, pool_sample, chunk_v_sample = trunk(
        x_sample, c_sample, state_hgrn, state_pool, min(POOL_STATE, PAST_LEN), True, *weights)
    return (y_prompt, y_sample, hgrn_prompt, pool_prompt, hgrn_sample, pool_sample, chunk_v_sample)
```

```cpp
#include <hip/hip_runtime.h>
#include <hip/hip_cooperative_groups.h>
#include <cstdio>
#include <cstdint>
namespace cg = cooperative_groups;

#define LAS __attribute__((address_space(3)))
typedef unsigned short bf16_t;
typedef short bf16x8 __attribute__((ext_vector_type(8)));
typedef float f32x4 __attribute__((ext_vector_type(4)));
typedef float f32x2 __attribute__((ext_vector_type(2)));
typedef unsigned u32x4 __attribute__((ext_vector_type(4)));
typedef unsigned u32x2 __attribute__((ext_vector_type(2)));

constexpr int D = 1024, NBP = 8, SEQ = 2048, MP = NBP * SEQ, MS = 128, MV = MP + MS, MPAD = 16640, DEPTH = 4;
constexpr int INC = 5888, ZC = 4864, FF = 2816, NADA = 6 * D, NMOD = DEPTH * NADA, NMODROW = NBP + MS;
constexpr int ZV = 0, ZG = 512, ZP = 1024, ZU = 1280, ZVC = 1536, ZGATE = 1792;
constexpr int QFKC = 1536;
constexpr int QFKB = 3072, QFK_Q = 2048;
constexpr int NSPAN = 8, SPAN = SEQ / NSPAN;
constexpr size_t MiB = 1u << 20;
constexpr size_t WS_WADA = 0;
constexpr size_t WS_MIX = 0;
constexpr size_t WS_WIN = 48 * MiB;
constexpr size_t WS_WBR = 94 * MiB;
constexpr size_t WS_WOUT = 102 * MiB;
constexpr size_t WS_WFI = 110 * MiB;
constexpr size_t WS_WFO = 154 * MiB;
constexpr size_t WS_COND = 176 * MiB;
constexpr size_t WS_LB = 176 * MiB + 512 * 1024;
constexpr size_t WS_MOD = 177 * MiB;
constexpr size_t WS_H = 190 * MiB;
constexpr size_t WS_Z = 223 * MiB;
constexpr size_t WS_QFK = 378 * MiB;
constexpr size_t WS_U = 476 * MiB;
constexpr size_t WS_DU = 492 * MiB;
constexpr size_t WS_CTL = 493 * MiB;
constexpr size_t CTL_BYTES = 16384;
constexpr size_t WS_CWS = 493 * MiB + 65536;
constexpr size_t WS_END = 494 * MiB;
constexpr size_t O_Y = 0, O_HP = (size_t)MV * D, O_PP = O_HP + (size_t)DEPTH * NBP * 4 * 16384, O_HS = O_PP + (size_t)DEPTH * NBP * 15 * 256,
                 O_PS = O_HS + (size_t)DEPTH * MS * 4 * 16384, O_CV = O_PS + (size_t)DEPTH * MS * 15 * 256;
constexpr int LDS_BYTES = 147456;

__device__ __forceinline__ unsigned cvt_pk_bf16(float lo, float hi) { unsigned r; asm volatile("v_cvt_pk_bf16_f32 %0, %1, %2" : "=v"(r) : "v"(lo), "v"(hi)); return r; }
__device__ __forceinline__ float bf2f(unsigned h) { return __uint_as_float(h << 16); }
__device__ __forceinline__ float bflo(unsigned w) { return __uint_as_float(w << 16); }
__device__ __forceinline__ float bfhi(unsigned w) { return __uint_as_float(w & 0xffff0000u); }
__device__ __forceinline__ float sigmoidf_(float x) { return __builtin_amdgcn_rcpf(1.0f + __expf(-x)); }
__device__ __forceinline__ float siluf_(float x) { return x * sigmoidf_(x); }
__device__ __forceinline__ float geluf_(float x) { const float y = 1.5957691216057308f * (x + 0.044715f * x * x * x); return x * sigmoidf_(y); }
__device__ __forceinline__ float wave_sum(float v) {
#pragma unroll
    for (int o = 1; o < 64; o <<= 1) v += __shfl_xor(v, o);
    return v;
}
__device__ __forceinline__ int TID() { int t = threadIdx.x; asm volatile("" : "+v"(t)); return t; }
constexpr int PTR_TBL_OFF = 131072 + 1024;
__device__ __forceinline__ const float* INP(int k) {
    extern __shared__ __attribute__((aligned(16))) unsigned char lds_raw_[];
    const LAS unsigned* t = (const LAS unsigned*)((LAS unsigned char*)lds_raw_ + PTR_TBL_OFF) + 2 * k;
    const unsigned lo = __builtin_amdgcn_readfirstlane(t[0]), hi = __builtin_amdgcn_readfirstlane(t[1]);
    return (const float*)(((unsigned long long)hi << 32) | lo);
}
#define LDS_BAR() do { asm volatile("s_waitcnt lgkmcnt(0)" ::: "memory"); __builtin_amdgcn_s_barrier(); asm volatile("" ::: "memory"); } while (0)
__device__ __forceinline__ int mod_row(int r) { return r < MP ? (r >> 11) : (NBP + r - MP); }

namespace pg8 {
constexpr int BM = 256, BK = 64, HALF = 128, HTB = HALF * BK * 2, STAGE_BYTES = 8 * HTB, NXCD = 8, WGM = 8;
__host__ __device__ __forceinline__ int lds_byte(int r, int c) { const int st = (r >> 4) * 2 + (c >> 5), rr = r & 15, cc = c & 31, ob = rr * 64 + cc * 2; return st * 1024 + (ob ^ (((ob >> 9) & 1) << 5)); }
__host__ __device__ __forceinline__ void stage_rc(int b, int& R, int& C) { const int st = b / 1024, sb = b % 1024, swz = sb ^ (((sb >> 9) & 1) << 5); R = (st >> 1) * 16 + swz / 64; C = (st & 1) * 32 + (swz % 64) / 2; }
__host__ __device__ __forceinline__ int perm32(int rho) { const int n = rho >> 4, i = rho & 15; return 8 * (i >> 2) + 4 * n + (i & 3); }

struct Unit { int pm, pn, kofs, nt, sub; };
struct Gemm { const bf16_t* A; const bf16_t* Bt; int lda, ldb; };

template <int SUBS>
struct Order {
    int nM, nN, nwg, G, c, extra, nt0, pofs;
    __device__ void init(int nM_, int nN_, int G_, int c_, int extra_, int nt) { nM = nM_; nN = nN_; nwg = nM * nN; G = G_; c = c_; extra = extra_; nt0 = nt; pofs = 0; }
    __device__ bool next(int i, Unit& u) const {
        const int round = i / SUBS, sub = i - round * SUBS;
        const long L = (long)round * G + c;
        if (L >= nwg + extra) return false;
        u.sub = sub;
        if (SUBS == 3) { u.kofs = sub == 0 ? 0 : 256 + 256 * sub; u.nt = sub == 0 ? 8 : 4; } else { u.kofs = 0; u.nt = nt0; }
        if (L >= nwg) { u.pm = nM; u.pn = (int)(L - nwg); return true; }
        int wgid = (int)L; { const int q = nwg / NXCD, r = nwg % NXCD, xcd = wgid % NXCD, off = wgid / NXCD; wgid = (xcd < r ? xcd * (q + 1) : r * (q + 1) + (xcd - r) * q) + off; }
        const int nig = WGM * nN, gid = wgid / nig, fm = gid * WGM, gsz = (nM - fm) < WGM ? (nM - fm) : WGM;
        u.pm = fm + ((wgid % nig) % gsz); u.pn = pofs + (wgid % nig) / gsz; return true;
    }
};

template <class Epi, bool ALIGN_EPI, int SUBS>
__device__ __forceinline__ void gemm_phase(LAS unsigned char* lds, const Gemm g, const Order<SUBS>& S, const Epi& E) {
    const int tid = TID(), wid = __builtin_amdgcn_readfirstlane(tid >> 6), lane = tid & 63, wr = wid >> 2, wc = wid & 3, fr = lane & 15, fq = lane >> 4;
    unsigned voffA[2], voffB[2];
#pragma unroll
    for (int i = 0; i < 2; ++i) { int R, C; stage_rc(tid * 16 + i * 8192, R, C); const int Rb = Epi::PERM ? ((R & ~31) + perm32(R & 31)) : R;
        voffA[i] = (unsigned)(R * g.lda + C) * 2u; voffB[i] = (unsigned)(Rb * g.ldb + C) * 2u; }
    const size_t kstep = (size_t)(BK * 2);
    const size_t hstepA = (size_t)HALF * g.lda * 2, hstepB = (size_t)HALF * g.ldb * 2;
    const unsigned ldsw = (unsigned)wid * 1024u;
    const int aoff = lds_byte(wr * 64 + fr, fq * 8), boff = lds_byte(wc * 32 + fr, fq * 8);
#define PG8_SA(b, h) (((b) * 2 + (h)) * HTB)
#define PG8_SB(b, h) ((4 + (b) * 2 + (h)) * HTB)
#define PG8_STAGE(bufoff, gbase, voff) do { _Pragma("unroll") for (int _i = 0; _i < 2; ++_i) \
        __builtin_amdgcn_global_load_lds((const unsigned*)((const char*)(gbase) + (voff)[_i]), (LAS unsigned*)(lds + (bufoff) + ldsw + _i * 8192), 16, 0, 0); } while (0)
#define PG8_LDA(dst, b, h) do { _Pragma("unroll") for (int m = 0; m < 4; ++m) _Pragma("unroll") for (int k = 0; k < 2; ++k) dst[m][k] = *(const LAS bf16x8*)(lds + PG8_SA(b, h) + aoff + m * 2048 + k * 1024); } while (0)
#define PG8_LDB(dst, b, h) do { _Pragma("unroll") for (int n = 0; n < 2; ++n) _Pragma("unroll") for (int k = 0; k < 2; ++k) dst[n][k] = *(const LAS bf16x8*)(lds + PG8_SB(b, h) + boff + n * 2048 + k * 1024); } while (0)
#define PG8_MMA(ai, bj, At, Bt) do { __builtin_amdgcn_s_setprio(1); _Pragma("unroll") for (int m = 0; m < 4; ++m) _Pragma("unroll") for (int n = 0; n < 2; ++n) _Pragma("unroll") for (int k = 0; k < 2; ++k) \
        acc[ai][bj][m][n] = __builtin_amdgcn_mfma_f32_16x16x32_bf16(Bt[n][k], At[m][k], acc[ai][bj][m][n], 0, 0, 0); __builtin_amdgcn_s_setprio(0); } while (0)
#define PG8_WAIT_V(n) asm volatile("s_waitcnt vmcnt(" #n ")" ::: "memory")
#define PG8_WAIT_L(n) asm volatile("s_waitcnt lgkmcnt(" #n ")" ::: "memory")
#define PG8_BAR __builtin_amdgcn_s_barrier()
#define PG8_SCHED __builtin_amdgcn_sched_barrier(0)
    Unit cur, nxt; int ui = 0;
    if (!S.next(0, cur)) return;
    f32x4 acc[2][2][4][2];
#pragma unroll
    for (int a = 0; a < 2; ++a)
#pragma unroll
        for (int b = 0; b < 2; ++b)
#pragma unroll
            for (int m = 0; m < 4; ++m)
#pragma unroll
                for (int n = 0; n < 2; ++n) acc[a][b][m][n] = (f32x4){0.f, 0.f, 0.f, 0.f};
    bf16x8 At[4][2], B0[2][2], B1[2][2];
    const char* cA = (const char*)g.A + (size_t)cur.pm * 2 * hstepA + (size_t)cur.kofs * 2; const char* cB = (const char*)g.Bt + (size_t)cur.pn * 2 * hstepB + (size_t)cur.kofs * 2;
    PG8_STAGE(PG8_SB(0, 0), cB, voffB); PG8_STAGE(PG8_SB(0, 1), cB + hstepB, voffB); PG8_STAGE(PG8_SA(0, 0), cA, voffA); PG8_STAGE(PG8_SA(0, 1), cA + hstepA, voffA);
    if (wr == 1) PG8_BAR;
    PG8_WAIT_V(2); PG8_BAR;
    PG8_STAGE(PG8_SB(1, 0), cB + kstep, voffB); PG8_STAGE(PG8_SA(1, 0), cA + kstep, voffA); PG8_STAGE(PG8_SB(1, 1), cB + hstepB + kstep, voffB);
    PG8_WAIT_V(6); PG8_BAR;
    for (;;) {
        const bool has_next = S.next(ui + 1, nxt);
        const char* nA = has_next ? (const char*)g.A + (size_t)nxt.pm * 2 * hstepA + (size_t)nxt.kofs * 2 : cA; const char* nB = has_next ? (const char*)g.Bt + (size_t)nxt.pn * 2 * hstepB + (size_t)nxt.kofs * 2 : cB;
        const int nt = cur.nt;
        for (int t = 0; t < nt; t += 2) {
            if constexpr (Epi::MIDK) { if (t == 8 || t == 12) E.mid(acc, cur, t == 8 ? 0 : 1, wr, wc, fr, fq); }
            const bool last = (t == nt - 2);
            const char* a1 = cA + (size_t)(t + 1) * kstep;
            const char* a2 = last ? nA : cA + (size_t)(t + 2) * kstep; const char* b2 = last ? nB : cB + (size_t)(t + 2) * kstep;
            const char* a3 = a2 + kstep; const char* b3 = b2 + kstep;
            PG8_LDB(B0, 0, 0); PG8_LDB(B1, 0, 1); PG8_SCHED; PG8_LDA(At, 0, 0); PG8_STAGE(PG8_SA(1, 1), a1 + hstepA, voffA);
            PG8_WAIT_V(8); PG8_WAIT_L(0); PG8_BAR; PG8_MMA(0, 0, At, B0); PG8_MMA(0, 1, At, B1); PG8_BAR; PG8_SCHED;
            PG8_LDA(At, 0, 1); PG8_STAGE(PG8_SB(0, 0), b2, voffB); PG8_STAGE(PG8_SB(0, 1), b2 + hstepB, voffB); PG8_STAGE(PG8_SA(0, 0), a2, voffA);
            PG8_WAIT_V(8); PG8_WAIT_L(0); PG8_BAR; PG8_MMA(1, 0, At, B0); PG8_MMA(1, 1, At, B1); PG8_BAR; PG8_SCHED;
            PG8_LDB(B0, 1, 0); PG8_LDB(B1, 1, 1); PG8_SCHED; PG8_LDA(At, 1, 0); PG8_STAGE(PG8_SA(0, 1), a2 + hstepA, voffA);
            PG8_WAIT_V(8); PG8_WAIT_L(0); PG8_BAR; PG8_MMA(0, 0, At, B0); PG8_MMA(0, 1, At, B1); PG8_BAR; PG8_SCHED;
            PG8_LDA(At, 1, 1); PG8_STAGE(PG8_SB(1, 0), b3, voffB); PG8_STAGE(PG8_SB(1, 1), b3 + hstepB, voffB); PG8_STAGE(PG8_SA(1, 0), a3, voffA);
            PG8_WAIT_V(8); PG8_WAIT_L(0); PG8_BAR; PG8_MMA(1, 0, At, B0); PG8_MMA(1, 1, At, B1); PG8_BAR; PG8_SCHED;
        }
        if constexpr (ALIGN_EPI) { if (wr == 0) PG8_BAR; }
        E(acc, cur, wr, wc, fr, fq);
        if (!has_next) break;
#pragma unroll
        for (int a = 0; a < 2; ++a)
#pragma unroll
            for (int b = 0; b < 2; ++b)
#pragma unroll
                for (int m = 0; m < 4; ++m)
#pragma unroll
                    for (int n = 0; n < 2; ++n) acc[a][b][m][n] = (f32x4){0.f, 0.f, 0.f, 0.f};
        cur = nxt; cA = nA; cB = nB; ++ui;
        if constexpr (ALIGN_EPI) { if (wr == 1) PG8_BAR; }
    }
    PG8_WAIT_V(0);
    if constexpr (!ALIGN_EPI) { if (wr == 0) PG8_BAR; }
    PG8_BAR;
#undef PG8_SA
#undef PG8_SB
#undef PG8_STAGE
#undef PG8_LDA
#undef PG8_LDB
#undef PG8_MMA
#undef PG8_WAIT_V
#undef PG8_WAIT_L
#undef PG8_BAR
#undef PG8_SCHED
}

typedef f32x4 Acc[2][2][4][2];

struct EpiAda {
    static constexpr bool PERM = false, MIDK = false;
    float* MODp; const float* bias;
    __device__ __forceinline__ void operator()(const Acc& acc, const Unit& u, int wr, int wc, int fr, int fq) const {
        const int row0 = wr * 64 + fr, col0 = u.pn * BM + wc * 32 + 4 * fq;
#pragma unroll
        for (int ai = 0; ai < 2; ++ai)
#pragma unroll
            for (int m = 0; m < 4; ++m) { const int r = row0 + ai * HALF + m * 16; if (r < NMODROW) {
#pragma unroll
                for (int bj = 0; bj < 2; ++bj)
#pragma unroll
                    for (int n = 0; n < 2; ++n) { const int c = col0 + bj * HALF + n * 16; *(f32x4*)(MODp + (size_t)r * NMOD + c) = acc[ai][bj][m][n] + *(const f32x4*)(bias + c); } } }
    }
};

struct EpiIn {
    static constexpr bool PERM = true, MIDK = false;
    float* QFK; bf16_t* Z; const float* LB;
    __device__ __forceinline__ void operator()(const Acc& acc, const Unit& u, int wr, int wc, int fr, int fq) const {
        const int row0 = u.pm * BM + wr * 64 + fr, cb = wc * 32 + 8 * fq, pn = u.pn;
        if (pn < 2) {
#pragma unroll
            for (int ai = 0; ai < 2; ++ai)
#pragma unroll
                for (int m = 0; m < 4; ++m) { unsigned char* rp = (unsigned char*)QFK + (size_t)(row0 + ai * HALF + m * 16) * QFKB + QFK_Q + (pn * 256 + cb) * 2;
#pragma unroll
                    for (int bj = 0; bj < 2; ++bj) { const f32x4 v0 = acc[ai][bj][m][0], v1 = acc[ai][bj][m][1];
                        u32x4 w; w.x = cvt_pk_bf16(siluf_(v0[0]), siluf_(v0[1])); w.y = cvt_pk_bf16(siluf_(v0[2]), siluf_(v0[3])); w.z = cvt_pk_bf16(siluf_(v1[0]), siluf_(v1[1])); w.w = cvt_pk_bf16(siluf_(v1[2]), siluf_(v1[3]));
                        *(u32x4*)(rp + bj * HALF * 2) = w; } }
        } else if (pn < 4) {
            const int c0 = (pn - 2) * 256 + cb;
            f32x4 lb[2][2];
#pragma unroll
            for (int bj = 0; bj < 2; ++bj)
#pragma unroll
                for (int n = 0; n < 2; ++n) lb[bj][n] = *(const f32x4*)(LB + c0 + bj * HALF + 4 * n);
#pragma unroll
            for (int ai = 0; ai < 2; ++ai)
#pragma unroll
                for (int m = 0; m < 4; ++m) { unsigned char* rb = (unsigned char*)QFK + (size_t)(row0 + ai * HALF + m * 16) * QFKB;
#pragma unroll
                    for (int bj = 0; bj < 2; ++bj)
#pragma unroll
                        for (int n = 0; n < 2; ++n) { const f32x4 v = acc[ai][bj][m][n]; f32x4 ko;
#pragma unroll
                            for (int e = 0; e < 4; ++e) ko[e] = (1.0f - lb[bj][n][e]) * __builtin_amdgcn_rcpf(1.0f + __expf(v[e]));
                            *(f32x4*)(rb + (c0 + bj * HALF + 4 * n) * 4) = ko; } }
        } else {
            const int zc = (pn - 4) * 256 + cb;
            const int act = (pn < 6) ? 0 : (pn < 8) ? 1 : (pn == 8) ? 0 : (pn < 11) ? 2 : 3;
#pragma unroll
            for (int ai = 0; ai < 2; ++ai)
#pragma unroll
                for (int m = 0; m < 4; ++m) { bf16_t* rp = Z + (size_t)(row0 + ai * HALF + m * 16) * ZC + zc;
#pragma unroll
                    for (int bj = 0; bj < 2; ++bj) { f32x4 v0 = acc[ai][bj][m][0], v1 = acc[ai][bj][m][1];
                        if (act == 1) {
#pragma unroll
                            for (int e = 0; e < 4; ++e) { v0[e] = siluf_(v0[e]); v1[e] = siluf_(v1[e]); }
                        } else if (act == 2) {
#pragma unroll
                            for (int e = 0; e < 4; ++e) { v0[e] = geluf_(v0[e]); v1[e] = geluf_(v1[e]); }
                        } else if (act == 3) {
#pragma unroll
                            for (int e = 0; e < 4; ++e) { v0[e] = sigmoidf_(v0[e]); v1[e] = sigmoidf_(v1[e]); }
                        }
                        u32x4 w; w.x = cvt_pk_bf16(v0[0], v0[1]); w.y = cvt_pk_bf16(v0[2], v0[3]); w.z = cvt_pk_bf16(v1[0], v1[1]); w.w = cvt_pk_bf16(v1[2], v1[3]);
                        *(u32x4*)(rp + bj * HALF) = w; } }
        }
    }
};

struct EpiBranch {
    static constexpr bool PERM = true, MIDK = true;
    bf16_t* Mb; const bf16_t* Z;
    __device__ __forceinline__ void mid(Acc& acc, const Unit& u, int sub, int wr, int wc, int fr, int fq) const {
        const int row0 = u.pm * BM + wr * 64 + fr, col0 = u.pn * BM + wc * 32 + 8 * fq;
#pragma unroll
        for (int ai = 0; ai < 2; ++ai)
#pragma unroll
            for (int m = 0; m < 4; ++m) { const unsigned r = (unsigned)(row0 + ai * HALF + m * 16);
#pragma unroll
                for (int bj = 0; bj < 2; ++bj) { const int c = col0 + bj * HALF;
                    const unsigned bo = (r * ZC + ZGATE + sub * D + c) * 2u;
                    const u32x4 gn = *(const u32x4*)((const char*)Z + bo), gd = *(const u32x4*)((const char*)Z + bo + 2 * D);
                    f32x4& v0 = acc[ai][bj][m][0]; f32x4& v1 = acc[ai][bj][m][1];
                    v0[0] *= bflo(gn.x) * __builtin_amdgcn_rcpf(bflo(gd.x)); v0[1] *= bfhi(gn.x) * __builtin_amdgcn_rcpf(bfhi(gd.x)); v0[2] *= bflo(gn.y) * __builtin_amdgcn_rcpf(bflo(gd.y)); v0[3] *= bfhi(gn.y) * __builtin_amdgcn_rcpf(bfhi(gd.y));
                    v1[0] *= bflo(gn.z) * __builtin_amdgcn_rcpf(bflo(gd.z)); v1[1] *= bfhi(gn.z) * __builtin_amdgcn_rcpf(bfhi(gd.z)); v1[2] *= bflo(gn.w) * __builtin_amdgcn_rcpf(bflo(gd.w)); v1[3] *= bfhi(gn.w) * __builtin_amdgcn_rcpf(bfhi(gd.w)); }
                asm volatile("" ::: "memory"); }
    }
    __device__ __forceinline__ void operator()(const Acc& acc, const Unit& u, int wr, int wc, int fr, int fq) const {
        const int row0 = u.pm * BM + wr * 64 + fr, col0 = u.pn * BM + wc * 32 + 8 * fq;
#pragma unroll
        for (int ai = 0; ai < 2; ++ai)
#pragma unroll
            for (int m = 0; m < 4; ++m) { const unsigned r = (unsigned)(row0 + ai * HALF + m * 16);
#pragma unroll
                for (int bj = 0; bj < 2; ++bj) { const int c = col0 + bj * HALF;
                    const u32x4 gw = *(const u32x4*)((const char*)Z + (r * ZC + ZGATE + 2 * D + c) * 2u);
                    const f32x4 v0 = acc[ai][bj][m][0], v1 = acc[ai][bj][m][1];
                    u32x4 w;
                    w.x = cvt_pk_bf16(bflo(gw.x) * v0[0], bfhi(gw.x) * v0[1]); w.y = cvt_pk_bf16(bflo(gw.y) * v0[2], bfhi(gw.y) * v0[3]);
                    w.z = cvt_pk_bf16(bflo(gw.z) * v1[0], bfhi(gw.z) * v1[1]); w.w = cvt_pk_bf16(bflo(gw.w) * v1[2], bfhi(gw.w) * v1[3]);
                    *(u32x4*)((char*)Mb + (r * D + c) * 2u) = w; }
                asm volatile("" ::: "memory"); }
    }
};

struct EpiRes {
    static constexpr bool PERM = false, MIDK = false;
    float* X; const float* G; const float* XS;
    __device__ __forceinline__ void operator()(const Acc& acc, const Unit& u, int wr, int wc, int fr, int fq) const {
        const int row0 = u.pm * BM + wr * 64 + fr, col0 = u.pn * BM + wc * 32 + 4 * fq;
        const float* gp = G + (size_t)(u.pm >> 3) * NMOD + col0;
        f32x4 gv[2][2];
#pragma unroll
        for (int bj = 0; bj < 2; ++bj)
#pragma unroll
            for (int n = 0; n < 2; ++n) gv[bj][n] = *(const f32x4*)(gp + bj * HALF + n * 16);
#pragma unroll
        for (int ai = 0; ai < 2; ++ai)
#pragma unroll
            for (int m = 0; m < 4; ++m) { const size_t ro = (size_t)(row0 + ai * HALF + m * 16) * D + col0;
#pragma unroll
                for (int bj = 0; bj < 2; ++bj)
#pragma unroll
                    for (int n = 0; n < 2; ++n) { const size_t o = ro + bj * HALF + n * 16; *(f32x4*)(X + o) = *(const f32x4*)(XS + o) + gv[bj][n] * acc[ai][bj][m][n]; } }
    }
};

struct EpiFfn {
    static constexpr bool PERM = true, MIDK = false;
    bf16_t* ACT;
    __device__ __forceinline__ void operator()(const Acc& acc, const Unit& u, int wr, int wc, int fr, int fq) const {
        const int row0 = u.pm * BM + wr * 64 + fr, col0 = u.pn * HALF + wc * 32 + 8 * fq;
#pragma unroll
        for (int ai = 0; ai < 2; ++ai)
#pragma unroll
            for (int m = 0; m < 4; ++m) { bf16_t* rp = ACT + (size_t)(row0 + ai * HALF + m * 16) * FF + col0;
                const f32x4 g0 = acc[ai][0][m][0], g1 = acc[ai][0][m][1], u0 = acc[ai][1][m][0], u1 = acc[ai][1][m][1];
                u32x4 w; w.x = cvt_pk_bf16(siluf_(g0[0]) * u0[0], siluf_(g0[1]) * u0[1]); w.y = cvt_pk_bf16(siluf_(g0[2]) * u0[2], siluf_(g0[3]) * u0[3]);
                w.z = cvt_pk_bf16(siluf_(g1[0]) * u1[0], siluf_(g1[1]) * u1[1]); w.w = cvt_pk_bf16(siluf_(g1[2]) * u1[2], siluf_(g1[3]) * u1[3]);
                *(u32x4*)rp = w; }
    }
};
}

template <class F>
__device__ __forceinline__ void sample_gemm(LAS unsigned char* lds, const bf16_t* A  , int lda, const bf16_t* Bt, int ldb, int kofs, int K, const F& epi) {
    const int tid = TID(), wid = __builtin_amdgcn_readfirstlane(tid >> 6), lane = tid & 63, fr = lane & 15, fq = lane >> 4;
    LAS f32x4* red = (LAS f32x4*)lds;
    const int kw = K / 8;
    for (int it = blockIdx.x; it < 256; it += gridDim.x) {
        const int rb = it >> 6, cbk = it & 63;
        f32x4 a0 = (f32x4){0.f, 0.f, 0.f, 0.f}, a1 = a0;
        const bf16_t* ap = A + (size_t)(rb * 32 + fr) * lda + kofs + wid * kw + 8 * fq;
        const bf16_t* bp = Bt + (size_t)(cbk * 16 + fr) * ldb + kofs + wid * kw + 8 * fq;
        for (int k = 0; k < kw; k += 128) {
            bf16x8 av0[4], av1[4], bv[4];
#pragma unroll
            for (int q = 0; q < 4; ++q) if (k + 32 * q < kw) { av0[q] = *(const bf16x8*)(ap + k + 32 * q); av1[q] = *(const bf16x8*)(ap + (size_t)16 * lda + k + 32 * q); bv[q] = *(const bf16x8*)(bp + k + 32 * q); }
#pragma unroll
            for (int q = 0; q < 4; ++q) if (k + 32 * q < kw) { a0 = __builtin_amdgcn_mfma_f32_16x16x32_bf16(av0[q], bv[q], a0, 0, 0, 0); a1 = __builtin_amdgcn_mfma_f32_16x16x32_bf16(av1[q], bv[q], a1, 0, 0, 0); }
        }
        __syncthreads();
        red[(wid * 2 + 0) * 64 + lane] = a0; red[(wid * 2 + 1) * 64 + lane] = a1;
        __syncthreads();
        if (tid < 128) {
            const int mt = tid >> 6; f32x4 s = (f32x4){0.f, 0.f, 0.f, 0.f};
#pragma unroll
            for (int w = 0; w < 8; ++w) s += red[(w * 2 + mt) * 64 + lane];
            const int col = cbk * 16 + fr, rowb = rb * 32 + mt * 16 + 4 * fq;
#pragma unroll
            for (int i = 0; i < 4; ++i) epi(rowb + i, col, s[i]);
        }
    }
    __syncthreads();
}

struct SampEpiBranch { bf16_t* Mb; const bf16_t* Z; int sub;
    __device__ __forceinline__ void operator()(int r, int c, float v) const { const size_t row = (size_t)(MP + r); const float gt = bf2f(Z[row * ZC + ZGATE + sub * D + c]); const float mo = sub ? bf2f(Mb[row * D + c]) : 0.f;
        Mb[row * D + c] = (bf16_t)(cvt_pk_bf16(mo + gt * v, 0.f) & 0xffffu); } };
struct SampEpiRes { float* X; const float* Gm; const float* XS;
    __device__ __forceinline__ void operator()(int r, int c, float v) const { X[(size_t)(MP + r) * D + c] = XS[(size_t)r * D + c] + Gm[(size_t)(NBP + r) * NMOD + c] * v; } };

__device__ __forceinline__ void sample_gemm_branch(LAS unsigned char* lds, const bf16_t* A, const bf16_t* Bt, bf16_t* Mb, const bf16_t* Z) {
    const int tid = TID(), wid = __builtin_amdgcn_readfirstlane(tid >> 6), lane = tid & 63, fr = lane & 15, fq = lane >> 4;
    LAS f32x4* red = (LAS f32x4*)lds;
    for (int it = blockIdx.x; it < 256; it += gridDim.x) {
        const int rb = it >> 6, cbk = it & 63;
        f32x4 a0 = (f32x4){0.f, 0.f, 0.f, 0.f}, a1 = a0;
        const bf16_t* ap = A + (size_t)(rb * 32 + fr) * D + wid * 128 + 8 * fq;
        const bf16_t* bp = Bt + (size_t)(cbk * 16 + fr) * D + wid * 128 + 8 * fq;
        bf16x8 av0[4], av1[4], bv[4];
#pragma unroll
        for (int q = 0; q < 4; ++q) { av0[q] = *(const bf16x8*)(ap + 32 * q); av1[q] = *(const bf16x8*)(ap + (size_t)16 * D + 32 * q); bv[q] = *(const bf16x8*)(bp + 32 * q); }
        const int mt = tid >> 6, col = cbk * 16 + fr, rowb = rb * 32 + (mt & 1) * 16 + 4 * fq;
        unsigned short gt[4][3];
        if (tid < 128) {
#pragma unroll
            for (int i = 0; i < 4; ++i)
#pragma unroll
                for (int sb = 0; sb < 3; ++sb) gt[i][sb] = Z[(size_t)(MP + rowb + i) * ZC + ZGATE + sb * D + col]; }
#pragma unroll
        for (int q = 0; q < 4; ++q) { a0 = __builtin_amdgcn_mfma_f32_16x16x32_bf16(av0[q], bv[q], a0, 0, 0, 0); a1 = __builtin_amdgcn_mfma_f32_16x16x32_bf16(av1[q], bv[q], a1, 0, 0, 0); }
        __syncthreads();
        red[(wid * 2 + 0) * 64 + lane] = a0; red[(wid * 2 + 1) * 64 + lane] = a1;
        __syncthreads();
        if (tid < 128) {
            const f32x4 ya = (red[(0 * 2 + mt) * 64 + lane] + red[(1 * 2 + mt) * 64 + lane]) + (red[(2 * 2 + mt) * 64 + lane] + red[(3 * 2 + mt) * 64 + lane]);
            const f32x4 yb = red[(4 * 2 + mt) * 64 + lane] + red[(5 * 2 + mt) * 64 + lane];
            const f32x4 yc = red[(6 * 2 + mt) * 64 + lane] + red[(7 * 2 + mt) * 64 + lane];
#pragma unroll
            for (int i = 0; i < 4; ++i) { const float v = bf2f(gt[i][0]) * ya[i] + bf2f(gt[i][1]) * yb[i] + bf2f(gt[i][2]) * yc[i];
                Mb[(size_t)(MP + rowb + i) * D + col] = (bf16_t)(cvt_pk_bf16(v, 0.f) & 0xffffu); }
        }
    }
    __syncthreads();
}

__device__ __forceinline__ void transpose_item(const float* W, int N, bf16_t* WT, int ldt, int k0, int n0, int drow0, LAS float* scr, int lane) {
    float tv[32];
#pragma unroll
    for (int i = 0; i < 32; ++i) { const int kk = 2 * i + (lane >> 5); tv[i] = __builtin_nontemporal_load(W + (size_t)(k0 + kk) * N + n0 + (lane & 31)); }
#pragma unroll
    for (int i = 0; i < 32; ++i) { const int kk = 2 * i + (lane >> 5); scr[kk * 33 + (lane & 31)] = tv[i]; }
    asm volatile("s_waitcnt lgkmcnt(0)" ::: "memory");
    const int c = lane & 7;
#pragma unroll
    for (int j = 0; j < 4; ++j) { const int n = (lane >> 3) + 8 * j; const LAS float* s = scr + (8 * c) * 33 + n;
        u32x4 o; o.x = cvt_pk_bf16(s[0 * 33], s[1 * 33]); o.y = cvt_pk_bf16(s[2 * 33], s[3 * 33]); o.z = cvt_pk_bf16(s[4 * 33], s[5 * 33]); o.w = cvt_pk_bf16(s[6 * 33], s[7 * 33]);
        *(u32x4*)(WT + (size_t)(drow0 + n) * ldt + k0 + 8 * c) = o; }
    asm volatile("s_waitcnt lgkmcnt(0)" ::: "memory");
}

struct Args { const float* in[24]; float* out; unsigned char* ws; int ph_lo, ph_hi; };

__device__ __forceinline__ void prologue(const Args& a, LAS unsigned char* lds) {
    const int tid = TID(), lane = tid & 63, wave = __builtin_amdgcn_readfirstlane(tid >> 6);
    const int G = gridDim.x, gw = blockIdx.x * 8 + wave, NGW = G * 8;
    unsigned char* ws = a.ws;
    LAS float* scr = (LAS float*)(lds + wave * 16384);
    constexpr int I_ADA = 16 * 192, I_IN = 16 * 184, I_BA = 8 * 32, I_BC = 4 * 32, I_O = 16 * 32, I_FI = 16 * 176, I_FO = 44 * 32;
    constexpr int I_L = I_ADA + I_IN + I_BA + I_BC + I_O + I_FI + I_FO;
    for (int it = gw; it < DEPTH * I_L; it += NGW) {
        const int l = it / I_L; int r = it - l * I_L;
        if (r < I_ADA) { const int kb = r / 192, nb = r % 192; transpose_item(INP(6) + (size_t)l * D * NADA, NADA, (bf16_t*)(ws + WS_WADA) + (size_t)l * NADA * D, D, kb * 64, nb * 32, nb * 32, scr, lane); continue; } r -= I_ADA;
        if (r < I_IN) { const int kb = r / 184, nb = r % 184; transpose_item(INP(8) + (size_t)l * D * INC, INC, (bf16_t*)(ws + WS_WIN) + (size_t)l * INC * D, D, kb * 64, nb * 32, nb * 32, scr, lane); continue; } r -= I_IN;
        if (r < I_BA) { const int kb = r / 32, nb = r % 32; transpose_item(INP(17) + (size_t)l * 512 * D, D, (bf16_t*)(ws + WS_WBR) + (size_t)l * D * D, D, kb * 64, nb * 32, nb * 32, scr, lane); continue; } r -= I_BA;
        if (r < I_BC) { const int kb = r / 32, nb = r % 32; transpose_item(INP(19) + (size_t)l * 256 * D, D, (bf16_t*)(ws + WS_WBR) + (size_t)l * D * D + 768, D, kb * 64, nb * 32, nb * 32, scr, lane); continue; } r -= I_BC;
        if (r < I_O) { const int kb = r / 32, nb = r % 32; transpose_item(INP(20) + (size_t)l * D * D, D, (bf16_t*)(ws + WS_WOUT) + (size_t)l * D * D, D, kb * 64, nb * 32, nb * 32, scr, lane); continue; } r -= I_O;
        if (r < I_FI) { const int kb = r / 176, nb = r % 176; const int n0 = nb * 32; const int cc = n0 < FF ? n0 : n0 - FF; const int dr = (cc >> 7) * 256 + (n0 < FF ? 0 : 128) + (cc & 127);
            transpose_item(INP(21) + (size_t)l * D * 2 * FF, 2 * FF, (bf16_t*)(ws + WS_WFI) + (size_t)l * 2 * FF * D, D, kb * 64, n0, dr, scr, lane); continue; } r -= I_FI;
        { const int kb = r / 32, nb = r % 32; transpose_item(INP(22) + (size_t)l * FF * D, D, (bf16_t*)(ws + WS_WFO) + (size_t)l * D * FF, FF, kb * 64, nb * 32, nb * 32, scr, lane); }
    }
    for (int it = gw; it < DEPTH * 4 * 16 * 8; it += NGW) {
        const int l = it >> 9, g = (it >> 7) & 3, nblk = (it >> 3) & 15, c8 = it & 7, n = nblk * 64 + lane;
        const float* mp = INP(11) + ((size_t)(l * 4 + g) * 64 + c8 * 8) * 64; const float* sc = INP(12) + l * 256 + g * 64; const float* wb = INP(18) + ((size_t)l * 256 + g * 64) * D + n;
        float acc[8];
#pragma unroll
        for (int j = 0; j < 8; ++j) acc[j] = 0.f;
        for (int d0 = 0; d0 < 64; d0 += 16) { float wv[16];
#pragma unroll
            for (int dd = 0; dd < 16; ++dd) wv[dd] = wb[(size_t)(d0 + dd) * D];
#pragma unroll
            for (int dd = 0; dd < 16; ++dd) { const float w = wv[dd] * sc[d0 + dd];
#pragma unroll
                for (int j = 0; j < 8; ++j) acc[j] += mp[j * 64 + d0 + dd] * w; } }
        u32x4 o; o.x = cvt_pk_bf16(acc[0], acc[1]); o.y = cvt_pk_bf16(acc[2], acc[3]); o.z = cvt_pk_bf16(acc[4], acc[5]); o.w = cvt_pk_bf16(acc[6], acc[7]);
        *(u32x4*)((bf16_t*)(ws + WS_WBR) + (size_t)l * D * D + (size_t)n * D + 512 + g * 64 + c8 * 8) = o;
    }
    { bf16_t* Wc = (bf16_t*)(ws + WS_CWS); const float* src = INP(15);
      for (int i = blockIdx.x * 512 + tid; i < DEPTH * 4 * 128 * 128 / 4; i += G * 512) { const int e = i * 4, t = (e >> 7) & 127, s0 = e & 127; const f32x4 v = *(const f32x4*)(src + e);
          u32x2 o; o.x = cvt_pk_bf16(s0 <= t ? v[0] : 0.f, s0 + 1 <= t ? v[1] : 0.f); o.y = cvt_pk_bf16(s0 + 2 <= t ? v[2] : 0.f, s0 + 3 <= t ? v[3] : 0.f); *(u32x2*)(Wc + e) = o; } }
    { bf16_t* C = (bf16_t*)(ws + WS_COND);
      for (int i = blockIdx.x * 512 + tid; i < 256 * D / 4; i += G * 512) { const int row = i >> 8, c4 = (i & 255) * 4; f32x4 v = (f32x4){0.f, 0.f, 0.f, 0.f};
          if (row < NBP) v = *(const f32x4*)(INP(4) + (size_t)row * D + c4); else if (row < NMODROW) v = *(const f32x4*)(INP(5) + (size_t)(row - NBP) * D + c4);
          u32x2 o; o.x = cvt_pk_bf16(siluf_(v[0]), siluf_(v[1])); o.y = cvt_pk_bf16(siluf_(v[2]), siluf_(v[3])); *(u32x2*)(C + (size_t)row * D + c4) = o; } }
    if (blockIdx.x == 0) { float* LB = (float*)(ws + WS_LB); const float* lg = INP(9); const int k = tid;
        const float x0 = lg[k], x1 = lg[512 + k], x2 = lg[1024 + k], x3 = lg[1536 + k]; const float mx = fmaxf(fmaxf(x0, x1), fmaxf(x2, x3));
        const float e0 = expf(x0 - mx), e1 = expf(x1 - mx), e2 = expf(x2 - mx), e3 = expf(x3 - mx), inv = 1.0f / (e0 + e1 + e2 + e3);
        LB[k] = 0.f; LB[512 + k] = fmaxf(e1 * inv, 0.f); LB[1024 + k] = fmaxf((e1 + e2) * inv, 0.f); LB[1536 + k] = fmaxf((e1 + e2 + e3) * inv, 0.f); }
}

__device__ __forceinline__ void norm_phase(const Args& a, int l, int which, bool first) {
    const int tid_ = TID(), lane = tid_ & 63, wave = tid_ >> 6, gw = blockIdx.x * 8 + wave, NGW = gridDim.x * 8;
    float* X = a.out; bf16_t* H = (bf16_t*)(a.ws + WS_H); const float* MODp = (const float*)(a.ws + WS_MOD) + l * NADA + which * 3 * D;
    const float* xp = INP(0); const float* xs = INP(1);
    for (int rb = gw; rb < MV; rb += 4 * NGW) {
        f32x4 v[4][4]; float s[4];
#pragma unroll
        for (int q = 0; q < 4; ++q) { const int r = rb + q * NGW; s[q] = 0.f;
            if (r < MV) { const float* xr = first ? (r < MP ? xp + (size_t)r * D : xs + (size_t)(r - MP) * D) : X + (size_t)r * D;
#pragma unroll
                for (int j = 0; j < 4; ++j) v[q][j] = *(const f32x4*)(xr + 4 * lane + 256 * j); }
            else {
#pragma unroll
                for (int j = 0; j < 4; ++j) v[q][j] = (f32x4){0.f, 0.f, 0.f, 0.f}; } }
#pragma unroll
        for (int q = 0; q < 4; ++q)
#pragma unroll
            for (int j = 0; j < 4; ++j) s[q] += (v[q][j][0] * v[q][j][0] + v[q][j][1] * v[q][j][1]) + (v[q][j][2] * v[q][j][2] + v[q][j][3] * v[q][j][3]);
#pragma unroll
        for (int o = 1; o < 64; o <<= 1) {
#pragma unroll
            for (int q = 0; q < 4; ++q) s[q] += __shfl_xor(s[q], o); }
#pragma unroll
        for (int q = 0; q < 4; ++q) { const int r = rb + q * NGW; if (r < MV) {
            const float rstd = rsqrtf(s[q] * (1.0f / D) + 1e-6f);
            const float* mr = MODp + (size_t)mod_row(r) * NMOD;
#pragma unroll
            for (int j = 0; j < 4; ++j) { const int c = 4 * lane + 256 * j; const f32x4 sh = *(const f32x4*)(mr + c), sc = *(const f32x4*)(mr + D + c); const f32x4 o = v[q][j] * rstd * (sc + 1.0f) + sh;
                u32x2 w; w.x = cvt_pk_bf16(o[0], o[1]); w.y = cvt_pk_bf16(o[2], o[3]); *(u32x2*)(H + (size_t)r * D + c) = w; } } }
    }
}
__device__ __forceinline__ void final_phase(const Args& a) {
    const int tid_ = TID(), lane = tid_ & 63, wave = tid_ >> 6, gw = blockIdx.x * 8 + wave, NGW = gridDim.x * 8;
    float* X = a.out; const float* fg = INP(23);
    f32x4 fgv[4];
#pragma unroll
    for (int j = 0; j < 4; ++j) fgv[j] = *(const f32x4*)(fg + 4 * lane + 256 * j);
    for (int rb = gw; rb < MV; rb += 4 * NGW) {
        f32x4 v[4][4]; float s[4];
#pragma unroll
        for (int q = 0; q < 4; ++q) { const int r = rb + q * NGW; s[q] = 0.f;
#pragma unroll
            for (int j = 0; j < 4; ++j) v[q][j] = (r < MV) ? *(const f32x4*)(X + (size_t)r * D + 4 * lane + 256 * j) : (f32x4){0.f, 0.f, 0.f, 0.f}; }
#pragma unroll
        for (int q = 0; q < 4; ++q)
#pragma unroll
            for (int j = 0; j < 4; ++j) s[q] += (v[q][j][0] * v[q][j][0] + v[q][j][1] * v[q][j][1]) + (v[q][j][2] * v[q][j][2] + v[q][j][3] * v[q][j][3]);
#pragma unroll
        for (int o = 1; o < 64; o <<= 1) {
#pragma unroll
            for (int q = 0; q < 4; ++q) s[q] += __shfl_xor(s[q], o); }
#pragma unroll
        for (int q = 0; q < 4; ++q) { const int r = rb + q * NGW; if (r < MV) { const float rstd = rsqrtf(s[q] * (1.0f / D) + 1e-6f);
#pragma unroll
            for (int j = 0; j < 4; ++j) *(f32x4*)(X + (size_t)r * D + 4 * lane + 256 * j) = v[q][j] * rstd * fgv[j]; } }
    }
}

typedef __bf16 bf16x2_t __attribute__((ext_vector_type(2)));
__device__ __forceinline__ unsigned cvtpk(float lo, float hi) { f32x2 v = {lo, hi}; bf16x2_t b = __builtin_convertvector(v, bf16x2_t); return __builtin_bit_cast(unsigned, b); }
constexpr int HQ_P = 136, HK_P = 24, HO_P = 132;
template <bool PASS3>
__device__ __forceinline__ void hgrn_unit(const Args& a, LAS unsigned char* lds, int l, int b, int h, int j) {
    const int tid = TID(), lane = tid & 63, w = __builtin_amdgcn_readfirstlane(tid >> 6), c16 = lane & 15, g = lane >> 4;
    LAS bf16_t* QT = (LAS bf16_t*)lds;
    LAS bf16_t* KT = QT + 16 * HQ_P;
    LAS bf16_t* KH = KT + 16 * HQ_P;
    LAS bf16_t* VT = KH + 128 * HK_P;
    LAS float* DD = (LAS float*)(VT + 128 * HK_P);
    LAS float* TOT = DD + 128;
    LAS float* OB = TOT + 512;
    const float* QFK = (const float*)(a.ws + WS_QFK); const bf16_t* Z = (const bf16_t*)(a.ws + WS_Z);
    float* U = (float*)(a.ws + WS_U); float* DU = (float*)(a.ws + WS_DU);
    const int bh = b * 4 + h, t0 = b * SEQ + j * SPAN;
    const int pk = tid & 127, tq = tid >> 7;
    f32x4 S[8];
#pragma unroll
    for (int kt = 0; kt < 8; ++kt) S[kt] = (f32x4){0.f, 0.f, 0.f, 0.f};
    if (PASS3) {
        for (int jj = 0; jj < j; ++jj) { const float* up = U + (size_t)(bh * NSPAN + jj) * 16384 + (size_t)w * 2048 + lane * 4; const float* dp = DU + (size_t)(bh * NSPAN + jj) * 128;
#pragma unroll
            for (int kt = 0; kt < 8; ++kt) { const f32x4 dd = *(const f32x4*)(dp + 16 * kt + 4 * g);
                S[kt] = dd * S[kt] + *(const f32x4*)(up + kt * 256); } }
    }
    float bsum = 0.f;
    float rfA[2][4], rqA[2][4], rkA[2][4]; unsigned rvA[2][4];
#pragma unroll
    for (int pp = 0; pp < 2; ++pp)
#pragma unroll
        for (int i = 0; i < 4; ++i) { const size_t row = (size_t)(t0 + pp * 16 + 4 * tq + i); const unsigned char* bp = (const unsigned char*)QFK + row * QFKB; if (PASS3) rqA[pp][i] = bf2f(*(const bf16_t*)(bp + QFK_Q + (h * 128 + pk) * 2)); rkA[pp][i] = *(const float*)(bp + (h * 128 + pk) * 4); rfA[pp][i] = fmaxf(1.0f - rkA[pp][i], 1e-30f); rvA[pp][i] = Z[row * ZC + ZV + h * 128 + pk]; }
    const int tt_n = tid >> 5, c4_n = (tid & 31) * 4;
    f32x4 gn = (f32x4){0.f, 0.f, 0.f, 0.f};
    if (PASS3) gn = *(const f32x4*)(INP(10) + (size_t)l * 512 + h * 128 + c4_n);
    for (int blk2 = 0; blk2 < SPAN / 32; ++blk2)
#pragma unroll
    for (int par = 0; par < 2; ++par) {
        const int blk = 2 * blk2 + par;
        float (&rf)[4] = rfA[par]; float (&rq)[4] = rqA[par]; float (&rk)[4] = rkA[par]; unsigned (&rv)[4] = rvA[par];
        u32x2 gg = (u32x2){0u, 0u};
        if (PASS3) gg = *(const u32x2*)(Z + (size_t)(t0 + blk * 16 + tt_n) * ZC + ZG + h * 128 + c4_n);
        float p[4]; { float acc = 0.f;
#pragma unroll
            for (int i = 0; i < 4; ++i) { acc += __logf(rf[i]); p[i] = acc; } }
        TOT[tq * 128 + pk] = p[3];
        LDS_BAR();
        {
            const float t0_ = TOT[pk], t1_ = TOT[128 + pk], t2_ = TOT[256 + pk], t3_ = TOT[384 + pk];
            const float off = tq == 0 ? 0.f : tq == 1 ? t0_ : tq == 2 ? t0_ + t1_ : (t0_ + t1_) + t2_;
            const float b15 = (t0_ + t1_) + (t2_ + t3_);
            const float e15 = __expf(b15);
            float kh[4];
#pragma unroll
            for (int i = 0; i < 4; ++i) { const float bb = off + p[i]; const int t = 4 * tq + i;
                if (PASS3) { const float e = __expf(bb), en = __expf(-bb), kt_ = rk[i] * en; QT[t * HQ_P + pk] = (bf16_t)(cvtpk(rq[i] * e, 0.f) & 0xffffu); KT[t * HQ_P + pk] = (bf16_t)(cvtpk(kt_, 0.f) & 0xffffu);
                    kh[i] = kt_ * e15; }
                else kh[i] = rk[i] * __expf(b15 - bb); }
            *(LAS u32x2*)(KH + pk * HK_P + 4 * tq) = (u32x2){cvtpk(kh[0], kh[1]), cvtpk(kh[2], kh[3])};
            *(LAS u32x2*)(VT + pk * HK_P + 4 * tq) = (u32x2){rv[0] | (rv[1] << 16), rv[2] | (rv[3] << 16)};
            if (tq == 0) { DD[pk] = e15; bsum += b15; }
        }
        if (blk + 2 < SPAN / 16) {
#pragma unroll
            for (int i = 0; i < 4; ++i) { const size_t row = (size_t)(t0 + (blk + 2) * 16 + 4 * tq + i); const unsigned char* bp = (const unsigned char*)QFK + row * QFKB; if (PASS3) rq[i] = bf2f(*(const bf16_t*)(bp + QFK_Q + (h * 128 + pk) * 2)); rk[i] = *(const float*)(bp + (h * 128 + pk) * 4); rf[i] = fmaxf(1.0f - rk[i], 1e-30f); rv[i] = Z[row * ZC + ZV + h * 128 + pk]; }
        }
        LDS_BAR();
        {
            const bf16x8 zero8 = (bf16x8){0, 0, 0, 0, 0, 0, 0, 0};
            bf16x8 kaS[8]; f32x4 ddS[8];
            bf16x8 vb = zero8; if (g < 2) vb = *(const LAS bf16x8*)(VT + (16 * w + c16) * HK_P + 8 * g);
#pragma unroll
            for (int kt = 0; kt < 8; ++kt) { kaS[kt] = zero8; if (g < 2) kaS[kt] = *(const LAS bf16x8*)(KH + (16 * kt + c16) * HK_P + 8 * g); ddS[kt] = *(const LAS f32x4*)(DD + 16 * kt + 4 * g); }
            if (PASS3) {
                u32x2 q0[4], q1[4]; bf16x8 kaT[4], qbT[4];
#pragma unroll
                for (int s2 = 0; s2 < 4; ++s2) { q0[s2] = *(const LAS u32x2*)(QT + c16 * HQ_P + 32 * s2 + 4 * g); q1[s2] = *(const LAS u32x2*)(QT + c16 * HQ_P + 32 * s2 + 16 + 4 * g);
                    kaT[s2] = *(const LAS bf16x8*)(KT + c16 * HQ_P + 32 * s2 + 8 * g); qbT[s2] = *(const LAS bf16x8*)(QT + c16 * HQ_P + 32 * s2 + 8 * g); }
                const u32x2 vv = *(const LAS u32x2*)(VT + (16 * w + c16) * HK_P + 4 * g);
                __builtin_amdgcn_sched_barrier(0);
                f32x4 oT = (f32x4){0.f, 0.f, 0.f, 0.f}, AT = (f32x4){0.f, 0.f, 0.f, 0.f};
#pragma unroll
                for (int s2 = 0; s2 < 4; ++s2) {
                    const u32x4 aw = (u32x4){cvtpk(S[2 * s2][0], S[2 * s2][1]), cvtpk(S[2 * s2][2], S[2 * s2][3]), cvtpk(S[2 * s2 + 1][0], S[2 * s2 + 1][1]), cvtpk(S[2 * s2 + 1][2], S[2 * s2 + 1][3])};
                    const u32x4 bw = (u32x4){q0[s2].x, q0[s2].y, q1[s2].x, q1[s2].y};
                    oT = __builtin_amdgcn_mfma_f32_16x16x32_bf16(__builtin_bit_cast(bf16x8, aw), __builtin_bit_cast(bf16x8, bw), oT, 0, 0, 0);
                    AT = __builtin_amdgcn_mfma_f32_16x16x32_bf16(kaT[s2], qbT[s2], AT, 0, 0, 0);
                }
#pragma unroll
                for (int i = 0; i < 4; ++i) AT[i] = (4 * g + i <= c16) ? AT[i] : 0.f;
                const u32x4 atw = (u32x4){cvtpk(AT[0], AT[1]), cvtpk(AT[2], AT[3]), 0u, 0u};
                const u32x4 vw = (u32x4){vv.x, vv.y, 0u, 0u};
                oT = __builtin_amdgcn_mfma_f32_16x16x32_bf16(__builtin_bit_cast(bf16x8, vw), __builtin_bit_cast(bf16x8, atw), oT, 0, 0, 0);
                *(LAS f32x4*)(OB + c16 * HO_P + 16 * w + 4 * g) = oT;
            } else __builtin_amdgcn_sched_barrier(0);
#pragma unroll
            for (int kt = 0; kt < 8; ++kt) S[kt] = __builtin_amdgcn_mfma_f32_16x16x32_bf16(kaS[kt], vb, S[kt] * ddS[kt], 0, 0, 0);
        }
        LDS_BAR();
        if (PASS3) {
            const int tt = tid >> 5, c4 = (tid & 31) * 4;
            const f32x4 o = *(const LAS f32x4*)(OB + tt * HO_P + c4);
            float ss = (o[0] * o[0] + o[1] * o[1]) + (o[2] * o[2] + o[3] * o[3]);
#pragma unroll
            for (int m = 1; m < 32; m <<= 1) ss += __shfl_xor(ss, m);
            const float rstd = rsqrtf(ss * (1.0f / 128.0f) + 1e-6f);
            const size_t row = (size_t)(t0 + blk * 16 + tt);
            u32x2 wv; wv.x = cvtpk(o[0] * rstd * gn[0] * bflo(gg.x), o[1] * rstd * gn[1] * bfhi(gg.x)); wv.y = cvtpk(o[2] * rstd * gn[2] * bflo(gg.y), o[3] * rstd * gn[3] * bfhi(gg.y));
            *(u32x2*)((bf16_t*)(a.ws + WS_MIX) + row * D + h * 128 + c4) = wv;
        }
    }
    if (!PASS3) {
        float* up = U + (size_t)(bh * NSPAN + j) * 16384 + (size_t)w * 2048 + lane * 4;
#pragma unroll
        for (int kt = 0; kt < 8; ++kt) *(f32x4*)(up + kt * 256) = S[kt];
        if (tq == 0) DU[(size_t)(bh * NSPAN + j) * 128 + pk] = __expf(bsum);
    } else if (j == NSPAN - 1) {
        float* hp = a.out + O_HP + ((size_t)(l * NBP + b) * 4 + h) * 16384 + 16 * w + c16;
#pragma unroll
        for (int kt = 0; kt < 8; ++kt)
#pragma unroll
            for (int i = 0; i < 4; ++i) hp[(size_t)(16 * kt + 4 * g + i) * 128] = S[kt][i];
    }
    __syncthreads();
}

__device__ __forceinline__ void hgrn_sample_unit(const Args& a, LAS unsigned char* lds, int l, int b, int h) {
    const int tid = TID(), v = tid & 127, kq = tid >> 7;
    LAS float* red = (LAS float*)lds;
    const size_t row = (size_t)(MP + b);
    const unsigned char* qb_ = (const unsigned char*)(a.ws + WS_QFK) + row * QFKB; const float* qF = (const float*)qb_ + h * 128; const bf16_t* qQ = (const bf16_t*)(qb_ + QFK_Q) + h * 128; const bf16_t* Z = (const bf16_t*)(a.ws + WS_Z) + row * ZC;
    const float vv = bf2f(Z[ZV + h * 128 + v]);
    const float* sp = INP(2) + (((size_t)l * MS + b) * 4 + h) * 16384 + (size_t)(kq * 32) * 128 + v;
    float* so = a.out + O_HS + (((size_t)l * MS + b) * 4 + h) * 16384 + (size_t)(kq * 32) * 128 + v;
    float o = 0.f;
    float sv[32];
#pragma unroll
    for (int i = 0; i < 32; ++i) sv[i] = __builtin_nontemporal_load(sp + (size_t)i * 128);
#pragma unroll
    for (int i = 0; i < 32; ++i) { const int k = kq * 32 + i; const float kk_ = qF[k]; const float s = (1.0f - kk_) * sv[i] + kk_ * vv; __builtin_nontemporal_store(s, so + (size_t)i * 128); o += bf2f(qQ[k]) * s; }
    __syncthreads();
    red[kq * 128 + v] = o;
    __syncthreads();
    if (tid < 128) {
        const float ot = (red[v] + red[128 + v]) + (red[256 + v] + red[384 + v]);
        float ss = wave_sum(ot * ot);
        red[512 + (tid >> 6)] = ss;
    }
    __syncthreads();
    if (tid < 128) {
        const float ot = (red[v] + red[128 + v]) + (red[256 + v] + red[384 + v]);
        const float rstd = rsqrtf((red[512] + red[513]) * (1.0f / 128.0f) + 1e-6f);
        const float val = ot * rstd * INP(10)[(size_t)l * 512 + h * 128 + v] * bf2f(Z[ZG + h * 128 + v]);
        ((bf16_t*)(a.ws + WS_MIX))[row * D + h * 128 + v] = (bf16_t)(cvt_pk_bf16(val, 0.f) & 0xffffu);
    }
    __syncthreads();
}

__device__ __forceinline__ void pool_phase(const Args& a, int l) {
    const int gt = blockIdx.x * 512 + TID(), NT = gridDim.x * 512;
    const bf16_t* Z = (const bf16_t*)(a.ws + WS_Z); bf16_t* MIX = (bf16_t*)(a.ws + WS_MIX);
    for (int it = gt; it < MP * 32; it += NT) {
        const int r = it >> 5, c8 = (it & 31) * 8, t = r & (SEQ - 1), wnd = 2 << (c8 >> 6);
        const int n = (t + 1 < wnd) ? t + 1 : wnd;
        float s[8];
#pragma unroll
        for (int q = 0; q < 8; ++q) s[q] = 0.f;
        u32x4 cur = *(const u32x4*)(Z + (size_t)r * ZC + ZP + c8);
        u32x4 pv[15];
#pragma unroll
        for (int i = 1; i < 16; ++i) pv[i - 1] = (i < n) ? *(const u32x4*)(Z + (size_t)(r - i) * ZC + ZP + c8) : (u32x4){0u, 0u, 0u, 0u};
#pragma unroll
        for (int i = 0; i < 15; ++i) { const u32x4 p = pv[i];
            s[0] += bflo(p.x); s[1] += bfhi(p.x); s[2] += bflo(p.y); s[3] += bfhi(p.y); s[4] += bflo(p.z); s[5] += bfhi(p.z); s[6] += bflo(p.w); s[7] += bfhi(p.w); }
        const float x[8] = {bflo(cur.x), bfhi(cur.x), bflo(cur.y), bfhi(cur.y), bflo(cur.z), bfhi(cur.z), bflo(cur.w), bfhi(cur.w)};
        const float inv = 1.0f / (float)n; float z[8];
#pragma unroll
        for (int q = 0; q < 8; ++q) z[q] = (s[q] + x[q]) * inv - x[q];
        u32x4 o; o.x = cvt_pk_bf16(z[0], z[1]); o.y = cvt_pk_bf16(z[2], z[3]); o.z = cvt_pk_bf16(z[4], z[5]); o.w = cvt_pk_bf16(z[6], z[7]);
        *(u32x4*)(MIX + (size_t)r * D + 512 + c8) = o;
    }
    for (int it = gt; it < MS * 256; it += NT) {
        const int b = it >> 8, c = it & 255, wnd = 2 << (c >> 6);
        const float* st = INP(3) + ((size_t)l * MS + b) * 15 * 256 + c;
        const float x = bf2f(Z[(size_t)(MP + b) * ZC + ZP + c]);
        float stv[15];
#pragma unroll
        for (int i = 0; i < 15; ++i) stv[i] = st[(size_t)i * 256];
        float s = x;
#pragma unroll
        for (int i = 1; i < 16; ++i) s += (i < wnd) ? stv[15 - i] : 0.f;
        const float z = s / (float)wnd - x;
        MIX[(size_t)(MP + b) * D + 512 + c] = (bf16_t)(cvt_pk_bf16(z, 0.f) & 0xffffu);
        float* ps = a.out + O_PS + ((size_t)l * MS + b) * 15 * 256 + c;
#pragma unroll
        for (int i = 0; i < 14; ++i) ps[(size_t)i * 256] = stv[i + 1];
        ps[(size_t)14 * 256] = x;
    }
    for (int it = gt; it < NBP * 15 * 256; it += NT) {
        const int b = it / (15 * 256), rem = it - b * 15 * 256, i = rem >> 8, c = rem & 255;
        a.out[O_PP + ((size_t)l * NBP + b) * 15 * 256 + rem] = bf2f(Z[(size_t)(b * SEQ + SEQ - 15 + i) * ZC + ZP + c]);
    }
}

constexpr int GV_P = 136;
__device__ __forceinline__ void gating_unit(const Args& a, LAS unsigned char* lds, int l, int unit) {
    const int tid = TID(), lane = tid & 63, w = __builtin_amdgcn_readfirstlane(tid >> 6), c16 = lane & 15, g4 = lane >> 4;
    const int g = unit & 3, ch = (unit >> 2) & 15, b = unit >> 6, r0 = b * SEQ + ch * 128;
    LAS bf16_t* vnT = (LAS bf16_t*)lds;
    const bf16_t* Z = (const bf16_t*)(a.ws + WS_Z); bf16_t* MIX = (bf16_t*)(a.ws + WS_MIX);
    const float* lg = INP(13) + l * 256, * lbb = INP(14) + l * 256;
    __syncthreads();
    {
        const int c = 4 * lane; const bool mine = (lane >> 4) == g;
        const f32x4 gg = *(const f32x4*)(lg + c), bb = *(const f32x4*)(lbb + c);
        u32x2 pall[16];
#pragma unroll
        for (int i = 0; i < 16; ++i) pall[i] = *(const u32x2*)(Z + (size_t)(r0 + 16 * w + i) * ZC + ZVC + c);
#pragma unroll
        for (int q = 0; q < 4; ++q) {
            u32x2 p[4];
#pragma unroll
            for (int i = 0; i < 4; ++i) p[i] = pall[4 * q + i];
            float x[4][4], sm[4];
#pragma unroll
            for (int i = 0; i < 4; ++i) { x[i][0] = bflo(p[i].x); x[i][1] = bfhi(p[i].x); x[i][2] = bflo(p[i].y); x[i][3] = bfhi(p[i].y); sm[i] = (x[i][0] + x[i][1]) + (x[i][2] + x[i][3]); }
#pragma unroll
            for (int o = 1; o < 64; o <<= 1) {
#pragma unroll
                for (int i = 0; i < 4; ++i) sm[i] += __shfl_xor(sm[i], o); }
            float sq[4];
#pragma unroll
            for (int i = 0; i < 4; ++i) { const float mu = sm[i] * (1.0f / 256.0f);
#pragma unroll
                for (int e = 0; e < 4; ++e) x[i][e] -= mu;
                sq[i] = (x[i][0] * x[i][0] + x[i][1] * x[i][1]) + (x[i][2] * x[i][2] + x[i][3] * x[i][3]); }
#pragma unroll
            for (int o = 1; o < 64; o <<= 1) {
#pragma unroll
                for (int i = 0; i < 4; ++i) sq[i] += __shfl_xor(sq[i], o); }
            if (mine) {
#pragma unroll
                for (int i = 0; i < 4; ++i) { const float rstd = rsqrtf(sq[i] * (1.0f / 256.0f) + 1e-6f); const int sidx = 16 * w + 4 * q + i;
#pragma unroll
                    for (int e = 0; e < 4; ++e) vnT[((c & 63) + e) * GV_P + sidx] = (bf16_t)(cvt_pk_bf16(x[i][e] * rstd * gg[e] + bb[e], 0.f) & 0xffffu); }
            }
        }
    }
    __syncthreads();
    {
        const bf16_t* Wb = (const bf16_t*)(a.ws + WS_CWS) + (size_t)(l * 4 + g) * 16384 + (size_t)(16 * w + c16) * 128 + 8 * g4;
        const int nks = (w >> 1) + 1;
        bf16x8 af[4];
#pragma unroll
        for (int ks = 0; ks < 4; ++ks) af[ks] = (ks < nks) ? *(const bf16x8*)(Wb + 32 * ks) : (bf16x8){0, 0, 0, 0, 0, 0, 0, 0};
        const float* bs = INP(16) + (size_t)(l * 4 + g) * 128 + 16 * w + 4 * g4;
        const f32x4 bsv = *(const f32x4*)bs;
        unsigned short uu_[4][4];
#pragma unroll
        for (int ct = 0; ct < 4; ++ct)
#pragma unroll
            for (int i = 0; i < 4; ++i) uu_[ct][i] = Z[(size_t)(r0 + 16 * w + 4 * g4 + i) * ZC + ZU + g * 64 + 16 * ct + c16];
#pragma unroll
        for (int ct = 0; ct < 4; ++ct) {
            f32x4 acc = (f32x4){0.f, 0.f, 0.f, 0.f};
#pragma unroll
            for (int ks = 0; ks < 4; ++ks) if (ks < nks) { const bf16x8 bf = *(const LAS bf16x8*)(vnT + (16 * ct + c16) * GV_P + 32 * ks + 8 * g4); acc = __builtin_amdgcn_mfma_f32_16x16x32_bf16(af[ks], bf, acc, 0, 0, 0); }
#pragma unroll
            for (int i = 0; i < 4; ++i) { const size_t row = (size_t)(r0 + 16 * w + 4 * g4 + i); const int cc = g * 64 + 16 * ct + c16;
                const float uu = bf2f(uu_[ct][i]);
                MIX[row * D + 768 + cc] = (bf16_t)(cvt_pk_bf16(uu * (acc[i] + bsv[i]), 0.f) & 0xffffu); }
        }
    }
}
__device__ __forceinline__ void gating_sample(const Args& a, int l) {
    const int tid_ = TID(), lane = tid_ & 63, gw = blockIdx.x * 8 + (tid_ >> 6), NGW = gridDim.x * 8;
    const bf16_t* Z = (const bf16_t*)(a.ws + WS_Z); bf16_t* MIX = (bf16_t*)(a.ws + WS_MIX);
    for (int b = gw; b < MS; b += NGW) {
        const size_t row = (size_t)(MP + b);
        const u32x2 p = *(const u32x2*)(Z + row * ZC + ZVC + 4 * lane);
        const float x0 = bflo(p.x), x1 = bfhi(p.x), x2 = bflo(p.y), x3 = bfhi(p.y);
        const float mu = wave_sum((x0 + x1) + (x2 + x3)) * (1.0f / 256.0f);
        const float d0 = x0 - mu, d1 = x1 - mu, d2 = x2 - mu, d3 = x3 - mu;
        const float rstd = rsqrtf(wave_sum((d0 * d0 + d1 * d1) + (d2 * d2 + d3 * d3)) * (1.0f / 256.0f) + 1e-6f);
        const int c = 4 * lane, g = lane >> 4;
        const f32x4 gg = *(const f32x4*)(INP(13) + l * 256 + c), bb = *(const f32x4*)(INP(14) + l * 256 + c);
        const f32x4 vn = (f32x4){d0 * rstd * gg[0] + bb[0], d1 * rstd * gg[1] + bb[1], d2 * rstd * gg[2] + bb[2], d3 * rstd * gg[3] + bb[3]};
        *(f32x4*)(a.out + O_CV + ((size_t)l * MS + b) * 256 + c) = vn;
        const float w00 = INP(15)[(size_t)(l * 4 + g) * 16384], b0 = INP(16)[(size_t)(l * 4 + g) * 128];
        const u32x2 up = *(const u32x2*)(Z + row * ZC + ZU + c);
        u32x2 o; o.x = cvt_pk_bf16(bflo(up.x) * (w00 * vn[0] + b0), bfhi(up.x) * (w00 * vn[1] + b0)); o.y = cvt_pk_bf16(bflo(up.y) * (w00 * vn[2] + b0), bfhi(up.y) * (w00 * vn[3] + b0));
        *(u32x2*)(MIX + row * D + 768 + c) = o;
    }
}

#define XB_TMO      128
#define XB_XCNT(j)  (256  + 64 * (j))
#define XB_XSUB(j)  (1280 + 64 * (j))
#define XB_XGEN(j)  (2304 + 64 * (j))
#define XB_TOP      3328
#define XB_TOPGEN   3392
#define XCD_BAR_WORDS 3456
#define XB_SPIN_CAP (1u << 18)

__device__ __forceinline__ unsigned xb_ld(unsigned* p)              { return __hip_atomic_load(p, __ATOMIC_RELAXED, __HIP_MEMORY_SCOPE_AGENT); }
__device__ __forceinline__ unsigned xb_add(unsigned* p, unsigned v) { return __hip_atomic_fetch_add(p, v, __ATOMIC_RELAXED, __HIP_MEMORY_SCOPE_AGENT); }
__device__ __forceinline__ unsigned xb_xcc_id() { return (unsigned)__builtin_amdgcn_s_getreg((3 << 11) | 20) & 0xFu; }
#define XB_SPIN(cond, bar) do { unsigned _sp = 0; while (cond) { __builtin_amdgcn_s_sleep(1); \
    if ((++_sp & 255u) == 0u) { if (xb_ld(&(bar)[XB_TMO])) break; if (_sp > XB_SPIN_CAP) { atomicAdd(&(bar)[XB_TMO], 1u); break; } } } } while (0)

struct XcdBarrier {
    unsigned* bar; unsigned x;
    volatile LAS unsigned* st;
};

__device__ __forceinline__ XcdBarrier xcd_barrier_post(unsigned* bar, volatile LAS unsigned* st) {
    XcdBarrier b; b.bar = bar; b.x = xb_xcc_id(); b.st = st;
    if (threadIdx.x == 0) (void)xb_add(&bar[XB_XCNT(b.x)], 1u);
    return b;
}
__device__ __forceinline__ void xcd_barrier_complete(unsigned* bar, unsigned x, unsigned& nloc, unsigned& nx) {
    const unsigned G = gridDim.x * gridDim.y * gridDim.z;
    unsigned sum, cnt, mine, sp = 0u;
    for (;;) {
        sum = 0u; cnt = 0u; mine = 0u;
#pragma unroll
        for (unsigned j = 0; j < 16; ++j) { const unsigned c = xb_ld(&bar[XB_XCNT(j)]); sum += c; cnt += (c > 0u) ? 1u : 0u; mine = (j == x) ? c : mine; }
        if (sum == G) break;
        __builtin_amdgcn_s_sleep(1);
        if ((++sp & 255u) == 0u) { if (xb_ld(&bar[XB_TMO])) break; if (sp > XB_SPIN_CAP) { atomicAdd(&bar[XB_TMO], 1u); break; } }
    }
    nloc = mine > 0u ? mine : 1u; nx = cnt > 0u ? cnt : 1u;
}

__device__ __forceinline__ void xcd_barrier(const XcdBarrier& b) {
    asm volatile("s_waitcnt vmcnt(0)" ::: "memory");
    __syncthreads();
    if (threadIdx.x == 0) {
        unsigned* bar = b.bar;
        __builtin_amdgcn_s_waitcnt(0);
        unsigned nloc = b.st[0], nx = b.st[1];
        if (nloc == 0u) { xcd_barrier_complete(bar, b.x, nloc, nx); b.st[0] = nloc; b.st[1] = nx; }
        const unsigned old = xb_add(&bar[XB_XSUB(b.x)], 1u);
        const unsigned gen = old / nloc;
        if (old + 1u == (gen + 1u) * nloc) {
            __builtin_amdgcn_fence(__ATOMIC_RELEASE, "agent");
            asm volatile("s_waitcnt vmcnt(0)" ::: "memory");
            const unsigned og = xb_add(&bar[XB_TOP], 1u);
            const unsigned tg = og / nx;
            if (og + 1u == (tg + 1u) * nx) xb_add(&bar[XB_TOPGEN], 1u);
            else XB_SPIN(xb_ld(&bar[XB_TOPGEN]) == tg, bar);
            __builtin_amdgcn_fence(__ATOMIC_ACQUIRE, "agent");
            xb_add(&bar[XB_XGEN(b.x)], 1u);
            asm volatile("s_waitcnt vmcnt(0)" ::: "memory");
        } else {
            XB_SPIN(xb_ld(&bar[XB_XGEN(b.x)]) == gen, bar);
            __builtin_amdgcn_fence(__ATOMIC_ACQUIRE, "agent");
            asm volatile("s_waitcnt vmcnt(0)" ::: "memory");
        }
    }
    __syncthreads();
}

constexpr int NSUB = 10;
constexpr int N_PHASES = 2 + NSUB * DEPTH + 1;
#ifndef ENMASK
#define ENMASK 0xffff
#endif
#define EN(k) (((ENMASK) >> (k)) & 1)
__global__ void __launch_bounds__(512, 2) fwd_kernel(Args a) {
    extern __shared__ __attribute__((aligned(16))) unsigned char lds_raw[];
    LAS unsigned char* lds = (LAS unsigned char*)lds_raw;
    cg::grid_group grid = cg::this_grid();
    if (threadIdx.x == 0) { LAS unsigned long long* tb = (LAS unsigned long long*)(lds + PTR_TBL_OFF);
#define PT_(k) tb[k] = (unsigned long long)a.in[k];
        PT_(0) PT_(1) PT_(2) PT_(3) PT_(4) PT_(5) PT_(6) PT_(7) PT_(8) PT_(9) PT_(10) PT_(11) PT_(12) PT_(13) PT_(14) PT_(15) PT_(16) PT_(17) PT_(18) PT_(19) PT_(20) PT_(21) PT_(22) PT_(23)
#undef PT_
    }
    volatile LAS unsigned* bst = (volatile LAS unsigned*)(lds + 131072 + 512);
    if (threadIdx.x < 2) bst[threadIdx.x] = 0u;
    __syncthreads();
    XcdBarrier xbar = xcd_barrier_post((unsigned*)(a.ws + WS_CTL), bst);
#if defined(REPMASK)
    int rep_ = 0;
#endif
    for (int ph = a.ph_lo; ph < a.ph_hi; ++ph) {
        unsigned char* ws = a.ws; int G = gridDim.x, bx = blockIdx.x;
        asm volatile("" : "+s"(ws), "+s"(G), "+s"(bx));
#if defined(REPMASK)
        const int s__ = (ph - 2) % NSUB; const int ty_ = ph == 0 ? 0 : ph == 1 ? 1 : ph == N_PHASES - 1 ? 2 : (s__ == 0 || s__ == 7) ? 3 : (s__ == 1 || s__ == 4) ? 4 : s__ == 2 ? 5 : s__ == 3 ? 6 : s__ == 5 ? 7 : s__ == 8 ? 9 : 8;
#endif
        if (ph == 0) { if (EN(0)) prologue(a, lds); }
        else if (ph == 1 && EN(1)) {
            pg8::Gemm g{(const bf16_t*)(ws + WS_COND), (const bf16_t*)(ws + WS_WADA), D, D}; pg8::Order<1> S; S.init(1, NMOD / 256, G, bx, 0, D / 64);
            pg8::EpiAda E{(float*)(ws + WS_MOD), INP(7)};
            pg8::gemm_phase<pg8::EpiAda, true, 1>(lds, g, S, E);
        } else if (ph == N_PHASES - 1) { if (EN(2)) final_phase(a); }
        else if (ph == 1) {}
        else {
            const int l = (ph - 2) / NSUB, s = (ph - 2) % NSUB;
            if (s == 0) { if (EN(3)) norm_phase(a, l, 0, l == 0); }
            else if ((s == 1 || s == 4) && EN(4)) {
                pg8::Gemm g{(const bf16_t*)(ws + WS_H), (const bf16_t*)(ws + WS_WIN) + (size_t)l * INC * D, D, D}; pg8::Order<1> S;
                if (s == 1) S.init(MP / 256, 11, G, bx, INC / 256, D / 64); else { S.init(MP / 256, 12, G, bx, 0, D / 64); S.pofs = 11; }
                pg8::EpiIn E{(float*)(ws + WS_QFK), (bf16_t*)(ws + WS_Z), (const float*)(ws + WS_LB) + l * 512};
                pg8::gemm_phase<pg8::EpiIn, true, 1>(lds, g, S, E);
            } else if (s == 2 && EN(5)) {
#ifndef REPA
#define REPA 0
#endif
                for (int rp = 0; rp <= ((REPA >> 0) & 1); ++rp)
                for (int u = bx; u < NBP * 4 * (NSPAN - 1); u += G) { const int bh = u / (NSPAN - 1), j = u % (NSPAN - 1); hgrn_unit<false>(a, lds, l, bh >> 2, bh & 3, j); }
                for (int rp = 0; rp <= ((REPA >> 1) & 1); ++rp)
                pool_phase(a, l);
                for (int rp = 0; rp <= ((REPA >> 2) & 1); ++rp)
                for (int u = G - 1 - bx; u < NBP * 16 * 4; u += G) gating_unit(a, lds, l, u);
                gating_sample(a, l);
                __syncthreads();
                for (int rp = 0; rp <= ((REPA >> 3) & 1); ++rp)
                for (int u = G - 1 - bx; u < MS * 4; u += G) hgrn_sample_unit(a, lds, l, u >> 2, u & 3);
            } else if (s == 3 && EN(6)) {
                for (int u = bx; u < NBP * 4 * NSPAN; u += G) { const int bh = u >> 3, j = u & 7; hgrn_unit<true>(a, lds, l, bh >> 2, bh & 3, j); }
            } else if (s == 5 && EN(7)) {
                pg8::Gemm g{(const bf16_t*)(ws + WS_MIX), (const bf16_t*)(ws + WS_WBR) + (size_t)l * D * D, D, D}; pg8::Order<1> S; S.init(MP / 256, D / 256, G, bx, 0, D / 64);
                bf16_t* Mb = (bf16_t*)(ws + WS_H); const bf16_t* Z = (const bf16_t*)(ws + WS_Z);
                pg8::EpiBranch E{Mb, Z};
                pg8::gemm_phase<pg8::EpiBranch, true, 1>(lds, g, S, E);
                sample_gemm_branch(lds, g.A + (size_t)MP * D, g.Bt, Mb, Z);
            } else if ((s == 6 || s == 9) && EN(8)) {
                const bool ff = (s == 9);
                const float* Gm = (const float*)(ws + WS_MOD) + l * NADA + (ff ? 5 : 2) * D;
                pg8::Gemm g; if (ff) g = pg8::Gemm{(const bf16_t*)(ws + WS_Z), (const bf16_t*)(ws + WS_WFO) + (size_t)l * D * FF, FF, FF}; else g = pg8::Gemm{(const bf16_t*)(ws + WS_H), (const bf16_t*)(ws + WS_WOUT) + (size_t)l * D * D, D, D};
                pg8::Order<1> S; S.init(MP / 256, D / 256, G, bx, 0, ff ? FF / 64 : D / 64);
                const bool src_in = (!ff && l == 0);
                pg8::EpiRes E{a.out, Gm, src_in ? INP(0) : a.out};
                pg8::gemm_phase<pg8::EpiRes, true, 1>(lds, g, S, E);
                SampEpiRes epi{a.out, Gm, src_in ? INP(1) : a.out + (size_t)MP * D};
                sample_gemm(lds, g.A + (size_t)MP * g.lda, g.lda, g.Bt, g.ldb, 0, ff ? FF : D, epi);
            } else if (s == 7) { if (EN(3)) norm_phase(a, l, 1, false); }
            else if (s == 8 && EN(9)) {
                pg8::Gemm g{(const bf16_t*)(ws + WS_H), (const bf16_t*)(ws + WS_WFI) + (size_t)l * 2 * FF * D, D, D}; pg8::Order<1> S; S.init(MP / 256, 2 * FF / 256, G, bx, 2 * FF / 256, D / 64);
                pg8::EpiFfn E{(bf16_t*)(ws + WS_Z)};
                pg8::gemm_phase<pg8::EpiFfn, true, 1>(lds, g, S, E);
            }
        }
        if (ph + 1 < a.ph_hi) { if (ph == 0) grid.sync(); else xcd_barrier(xbar); }
#if defined(REPMASK)
        if (((REPMASK) >> ty_) & 1) { if (!rep_) { rep_ = 1; --ph; } else rep_ = 0; }
#endif
    }
}

#ifndef ONE_LAUNCH
#define ONE_LAUNCH 1
#endif
extern "C" void kernel_launch(void* const* d_in, const int* in_sizes, int n_in, void* d_out, int out_size, void* d_ws, size_t ws_size, hipStream_t stream) {
    static int grid = 0;
    if (grid == 0) {
        if (n_in != 24 || ws_size < WS_END) { fprintf(stderr, "kernel_launch: unexpected n_in %d or ws_size %zu (< %zu)\n", n_in, ws_size, (size_t)WS_END); grid = -1; return; }
        int dev = 0, cus = 0, per_cu = 0;
        hipGetDevice(&dev); hipDeviceGetAttribute(&cus, hipDeviceAttributeMultiprocessorCount, dev);
        if (hipFuncSetAttribute((const void*)fwd_kernel, hipFuncAttributeMaxDynamicSharedMemorySize, LDS_BYTES) != hipSuccess) { fprintf(stderr, "kernel_launch: hipFuncSetAttribute failed\n"); grid = -1; return; }
        if (hipOccupancyMaxActiveBlocksPerMultiprocessor(&per_cu, (const void*)fwd_kernel, 512, LDS_BYTES) != hipSuccess || per_cu < 1) { fprintf(stderr, "kernel_launch: occupancy query failed (%d)\n", per_cu); (void)hipGetLastError(); per_cu = 1; }
        grid = cus * (per_cu > 1 ? 1 : per_cu);
        fprintf(stderr, "kernel_launch: grid %d (cus %d, per_cu %d)\n", grid, cus, per_cu);
    }
    if (grid < 0) return;
    if (hipMemsetAsync((char*)d_ws + WS_CTL, 0, CTL_BYTES, stream) != hipSuccess) { fprintf(stderr, "kernel_launch: memset failed\n"); return; }
    Args a{};
    for (int i = 0; i < 24; ++i) a.in[i] = (const float*)d_in[i];
    a.out = (float*)d_out; a.ws = (unsigned char*)d_ws;
#if ONE_LAUNCH
    a.ph_lo = 0; a.ph_hi = N_PHASES;
    void* args[] = {&a};
    hipError_t e = hipLaunchCooperativeKernel((const void*)fwd_kernel, dim3(grid), dim3(512), args, LDS_BYTES, stream);
    if (e != hipSuccess) fprintf(stderr, "cooperative launch failed: %s (grid %d)\n", hipGetErrorString(e), grid);
#else
    for (int ph = 0; ph < N_PHASES; ++ph) {
        a.ph_lo = ph; a.ph_hi = ph + 1;
        hipLaunchKernelGGL(fwd_kernel, dim3(grid), dim3(512), LDS_BYTES, stream, a);
    }
#endif
}
```

```cpp
#include <hip/hip_runtime.h>
#include <hip/hip_cooperative_groups.h>
#include <cstdio>
#include <cstdint>
namespace cg = cooperative_groups;

#define LAS __attribute__((address_space(3)))
typedef unsigned short bf16_t;
typedef short bf16x8 __attribute__((ext_vector_type(8)));
typedef float f32x4 __attribute__((ext_vector_type(4)));
typedef float f32x2 __attribute__((ext_vector_type(2)));
typedef unsigned u32x4 __attribute__((ext_vector_type(4)));
typedef unsigned u32x2 __attribute__((ext_vector_type(2)));

constexpr int D = 1024, NBP = 8, SEQ = 2048, MP = NBP * SEQ, MS = 128, MV = MP + MS, MPAD = 16640, DEPTH = 4;
constexpr int INC = 5888, ZC = 4864, FF = 2816, NADA = 6 * D, NMOD = DEPTH * NADA, NMODROW = NBP + MS;
constexpr int ZV = 0, ZG = 512, ZP = 1024, ZU = 1280, ZVC = 1536, ZGATE = 1792;
constexpr int QFKC = 1536;
constexpr int QFKB = 3072, QFK_Q = 2048;
constexpr int NSPAN = 8, SPAN = SEQ / NSPAN;
constexpr size_t MiB = 1u << 20;
constexpr size_t WS_WADA = 0;
constexpr size_t WS_MIX = 0;
constexpr size_t WS_WIN = 48 * MiB;
constexpr size_t WS_WBR = 94 * MiB;
constexpr size_t WS_WOUT = 102 * MiB;
constexpr size_t WS_WFI = 110 * MiB;
constexpr size_t WS_WFO = 154 * MiB;
constexpr size_t WS_COND = 176 * MiB;
constexpr size_t WS_LB = 176 * MiB + 512 * 1024;
constexpr size_t WS_MOD = 177 * MiB;
constexpr size_t WS_H = 190 * MiB;
constexpr size_t WS_Z = 223 * MiB;
constexpr size_t WS_QFK = 378 * MiB;
constexpr size_t WS_U = 476 * MiB;
constexpr size_t WS_DU = 492 * MiB;
constexpr size_t WS_CTL = 493 * MiB;
constexpr size_t CTL_BYTES = 16384;
constexpr size_t WS_CWS = 493 * MiB + 65536;
constexpr size_t WS_END = 494 * MiB;
constexpr size_t O_Y = 0, O_HP = (size_t)MV * D, O_PP = O_HP + (size_t)DEPTH * NBP * 4 * 16384, O_HS = O_PP + (size_t)DEPTH * NBP * 15 * 256,
                 O_PS = O_HS + (size_t)DEPTH * MS * 4 * 16384, O_CV = O_PS + (size_t)DEPTH * MS * 15 * 256;
constexpr int LDS_BYTES = 147456;

__device__ __forceinline__ unsigned cvt_pk_bf16(float lo, float hi) { unsigned r; asm volatile("v_cvt_pk_bf16_f32 %0, %1, %2" : "=v"(r) : "v"(lo), "v"(hi)); return r; }
__device__ __forceinline__ float bf2f(unsigned h) { return __uint_as_float(h << 16); }
__device__ __forceinline__ float bflo(unsigned w) { return __uint_as_float(w << 16); }
__device__ __forceinline__ float bfhi(unsigned w) { return __uint_as_float(w & 0xffff0000u); }
__device__ __forceinline__ float sigmoidf_(float x) { return __builtin_amdgcn_rcpf(1.0f + __expf(-x)); }
__device__ __forceinline__ float siluf_(float x) { return x * sigmoidf_(x); }
__device__ __forceinline__ float geluf_(float x) { const float y = 1.5957691216057308f * (x + 0.044715f * x * x * x); return x * sigmoidf_(y); }
__device__ __forceinline__ float wave_sum(float v) {
#pragma unroll
    for (int o = 1; o < 64; o <<= 1) v += __shfl_xor(v, o);
    return v;
}
__device__ __forceinline__ int TID() { int t = threadIdx.x; asm volatile("" : "+v"(t)); return t; }
constexpr int PTR_TBL_OFF = 131072 + 1024;
__device__ __forceinline__ const float* INP(int k) {
    extern __shared__ __attribute__((aligned(16))) unsigned char lds_raw_[];
    const LAS unsigned* t = (const LAS unsigned*)((LAS unsigned char*)lds_raw_ + PTR_TBL_OFF) + 2 * k;
    const unsigned lo = __builtin_amdgcn_readfirstlane(t[0]), hi = __builtin_amdgcn_readfirstlane(t[1]);
    return (const float*)(((unsigned long long)hi << 32) | lo);
}
#define LDS_BAR() do { asm volatile("s_waitcnt lgkmcnt(0)" ::: "memory"); __builtin_amdgcn_s_barrier(); asm volatile("" ::: "memory"); } while (0)
__device__ __forceinline__ int mod_row(int r) { return r < MP ? (r >> 11) : (NBP + r - MP); }

namespace pg8 {
constexpr int BM = 256, BK = 64, HALF = 128, HTB = HALF * BK * 2, STAGE_BYTES = 8 * HTB, NXCD = 8, WGM = 8;
__host__ __device__ __forceinline__ int lds_byte(int r, int c) { const int st = (r >> 4) * 2 + (c >> 5), rr = r & 15, cc = c & 31, ob = rr * 64 + cc * 2; return st * 1024 + (ob ^ (((ob >> 9) & 1) << 5)); }
__host__ __device__ __forceinline__ void stage_rc(int b, int& R, int& C) { const int st = b / 1024, sb = b % 1024, swz = sb ^ (((sb >> 9) & 1) << 5); R = (st >> 1) * 16 + swz / 64; C = (st & 1) * 32 + (swz % 64) / 2; }
__host__ __device__ __forceinline__ int perm32(int rho) { const int n = rho >> 4, i = rho & 15; return 8 * (i >> 2) + 4 * n + (i & 3); }

struct Unit { int pm, pn, kofs, nt, sub; };
struct Gemm { const bf16_t* A; const bf16_t* Bt; int lda, ldb; };

template <int SUBS>
struct Order {
    int nM, nN, nwg, G, c, extra, nt0, pofs;
    __device__ void init(int nM_, int nN_, int G_, int c_, int extra_, int nt) { nM = nM_; nN = nN_; nwg = nM * nN; G = G_; c = c_; extra = extra_; nt0 = nt; pofs = 0; }
    __device__ bool next(int i, Unit& u) const {
        const int round = i / SUBS, sub = i - round * SUBS;
        const long L = (long)round * G + c;
        if (L >= nwg + extra) return false;
        u.sub = sub;
        if (SUBS == 3) { u.kofs = sub == 0 ? 0 : 256 + 256 * sub; u.nt = sub == 0 ? 8 : 4; } else { u.kofs = 0; u.nt = nt0; }
        if (L >= nwg) { u.pm = nM; u.pn = (int)(L - nwg); return true; }
        int wgid = (int)L; { const int q = nwg / NXCD, r = nwg % NXCD, xcd = wgid % NXCD, off = wgid / NXCD; wgid = (xcd < r ? xcd * (q + 1) : r * (q + 1) + (xcd - r) * q) + off; }
        const int nig = WGM * nN, gid = wgid / nig, fm = gid * WGM, gsz = (nM - fm) < WGM ? (nM - fm) : WGM;
        u.pm = fm + ((wgid % nig) % gsz); u.pn = pofs + (wgid % nig) / gsz; return true;
    }
};

template <class Epi, bool ALIGN_EPI, int SUBS>
__device__ __forceinline__ void gemm_phase(LAS unsigned char* lds, const Gemm g, const Order<SUBS>& S, const Epi& E) {
    const int tid = TID(), wid = __builtin_amdgcn_readfirstlane(tid >> 6), lane = tid & 63, wr = wid >> 2, wc = wid & 3, fr = lane & 15, fq = lane >> 4;
    unsigned voffA[2], voffB[2];
#pragma unroll
    for (int i = 0; i < 2; ++i) { int R, C; stage_rc(tid * 16 + i * 8192, R, C); const int Rb = Epi::PERM ? ((R & ~31) + perm32(R & 31)) : R;
        voffA[i] = (unsigned)(R * g.lda + C) * 2u; voffB[i] = (unsigned)(Rb * g.ldb + C) * 2u; }
    const size_t kstep = (size_t)(BK * 2);
    const size_t hstepA = (size_t)HALF * g.lda * 2, hstepB = (size_t)HALF * g.ldb * 2;
    const unsigned ldsw = (unsigned)wid * 1024u;
    const int aoff = lds_byte(wr * 64 + fr, fq * 8), boff = lds_byte(wc * 32 + fr, fq * 8);
#define PG8_SA(b, h) (((b) * 2 + (h)) * HTB)
#define PG8_SB(b, h) ((4 + (b) * 2 + (h)) * HTB)
#define PG8_STAGE(bufoff, gbase, voff) do { _Pragma("unroll") for (int _i = 0; _i < 2; ++_i) \
        __builtin_amdgcn_global_load_lds((const unsigned*)((const char*)(gbase) + (voff)[_i]), (LAS unsigned*)(lds + (bufoff) + ldsw + _i * 8192), 16, 0, 0); } while (0)
#define PG8_LDA(dst, b, h) do { _Pragma("unroll") for (int m = 0; m < 4; ++m) _Pragma("unroll") for (int k = 0; k < 2; ++k) dst[m][k] = *(const LAS bf16x8*)(lds + PG8_SA(b, h) + aoff + m * 2048 + k * 1024); } while (0)
#define PG8_LDB(dst, b, h) do { _Pragma("unroll") for (int n = 0; n < 2; ++n) _Pragma("unroll") for (int k = 0; k < 2; ++k) dst[n][k] = *(const LAS bf16x8*)(lds + PG8_SB(b, h) + boff + n * 2048 + k * 1024); } while (0)
#define PG8_MMA(ai, bj, At, Bt) do { __builtin_amdgcn_s_setprio(1); _Pragma("unroll") for (int m = 0; m < 4; ++m) _Pragma("unroll") for (int n = 0; n < 2; ++n) _Pragma("unroll") for (int k = 0; k < 2; ++k) \
        acc[ai][bj][m][n] = __builtin_amdgcn_mfma_f32_16x16x32_bf16(Bt[n][k], At[m][k], acc[ai][bj][m][n], 0, 0, 0); __builtin_amdgcn_s_setprio(0); } while (0)
#define PG8_WAIT_V(n) asm volatile("s_waitcnt vmcnt(" #n ")" ::: "memory")
#define PG8_WAIT_L(n) asm volatile("s_waitcnt lgkmcnt(" #n ")" ::: "memory")
#define PG8_BAR __builtin_amdgcn_s_barrier()
#define PG8_SCHED __builtin_amdgcn_sched_barrier(0)
    Unit cur, nxt; int ui = 0;
    if (!S.next(0, cur)) return;
    f32x4 acc[2][2][4][2];
#pragma unroll
    for (int a = 0; a < 2; ++a)
#pragma unroll
        for (int b = 0; b < 2; ++b)
#pragma unroll
            for (int m = 0; m < 4; ++m)
#pragma unroll
                for (int n = 0; n < 2; ++n) acc[a][b][m][n] = (f32x4){0.f, 0.f, 0.f, 0.f};
    bf16x8 At[4][2], B0[2][2], B1[2][2];
    const char* cA = (const char*)g.A + (size_t)cur.pm * 2 * hstepA + (size_t)cur.kofs * 2; const char* cB = (const char*)g.Bt + (size_t)cur.pn * 2 * hstepB + (size_t)cur.kofs * 2;
    PG8_STAGE(PG8_SB(0, 0), cB, voffB); PG8_STAGE(PG8_SB(0, 1), cB + hstepB, voffB); PG8_STAGE(PG8_SA(0, 0), cA, voffA); PG8_STAGE(PG8_SA(0, 1), cA + hstepA, voffA);
    if (wr == 1) PG8_BAR;
    PG8_WAIT_V(2); PG8_BAR;
    PG8_STAGE(PG8_SB(1, 0), cB + kstep, voffB); PG8_STAGE(PG8_SA(1, 0), cA + kstep, voffA); PG8_STAGE(PG8_SB(1, 1), cB + hstepB + kstep, voffB);
    PG8_WAIT_V(6); PG8_BAR;
    for (;;) {
        const bool has_next = S.next(ui + 1, nxt);
        const char* nA = has_next ? (const char*)g.A + (size_t)nxt.pm * 2 * hstepA + (size_t)nxt.kofs * 2 : cA; const char* nB = has_next ? (const char*)g.Bt + (size_t)nxt.pn * 2 * hstepB + (size_t)nxt.kofs * 2 : cB;
        const int nt = cur.nt;
        for (int t = 0; t < nt; t += 2) {
            if constexpr (Epi::MIDK) { if (t == 8 || t == 12) E.mid(acc, cur, t == 8 ? 0 : 1, wr, wc, fr, fq); }
            const bool last = (t == nt - 2);
            const char* a1 = cA + (size_t)(t + 1) * kstep;
            const char* a2 = last ? nA : cA + (size_t)(t + 2) * kstep; const char* b2 = last ? nB : cB + (size_t)(t + 2) * kstep;
            const char* a3 = a2 + kstep; const char* b3 = b2 + kstep;
            PG8_LDB(B0, 0, 0); PG8_LDB(B1, 0, 1); PG8_SCHED; PG8_LDA(At, 0, 0); PG8_STAGE(PG8_SA(1, 1), a1 + hstepA, voffA);
            PG8_WAIT_V(8); PG8_WAIT_L(0); PG8_BAR; PG8_MMA(0, 0, At, B0); PG8_MMA(0, 1, At, B1); PG8_BAR; PG8_SCHED;
            PG8_LDA(At, 0, 1); PG8_STAGE(PG8_SB(0, 0), b2, voffB); PG8_STAGE(PG8_SB(0, 1), b2 + hstepB, voffB); PG8_STAGE(PG8_SA(0, 0), a2, voffA);
            PG8_WAIT_V(8); PG8_WAIT_L(0); PG8_BAR; PG8_MMA(1, 0, At, B0); PG8_MMA(1, 1, At, B1); PG8_BAR; PG8_SCHED;
            PG8_LDB(B0, 1, 0); PG8_LDB(B1, 1, 1); PG8_SCHED; PG8_LDA(At, 1, 0); PG8_STAGE(PG8_SA(0, 1), a2 + hstepA, voffA);
            PG8_WAIT_V(8); PG8_WAIT_L(0); PG8_BAR; PG8_MMA(0, 0, At, B0); PG8_MMA(0, 1, At, B1); PG8_BAR; PG8_SCHED;
            PG8_LDA(At, 1, 1); PG8_STAGE(PG8_SB(1, 0), b3, voffB); PG8_STAGE(PG8_SB(1, 1), b3 + hstepB, voffB); PG8_STAGE(PG8_SA(1, 0), a3, voffA);
            PG8_WAIT_V(8); PG8_WAIT_L(0); PG8_BAR; PG8_MMA(1, 0, At, B0); PG8_MMA(1, 1, At, B1); PG8_BAR; PG8_SCHED;
        }
        if constexpr (ALIGN_EPI) { if (wr == 0) PG8_BAR; }
        E(acc, cur, wr, wc, fr, fq);
        if (!has_next) break;
#pragma unroll
        for (int a = 0; a < 2; ++a)
#pragma unroll
            for (int b = 0; b < 2; ++b)
#pragma unroll
                for (int m = 0; m < 4; ++m)
#pragma unroll
                    for (int n = 0; n < 2; ++n) acc[a][b][m][n] = (f32x4){0.f, 0.f, 0.f, 0.f};
        cur = nxt; cA = nA; cB = nB; ++ui;
        if constexpr (ALIGN_EPI) { if (wr == 1) PG8_BAR; }
    }
    PG8_WAIT_V(0);
    if constexpr (!ALIGN_EPI) { if (wr == 0) PG8_BAR; }
    PG8_BAR;
#undef PG8_SA
#undef PG8_SB
#undef PG8_STAGE
#undef PG8_LDA
#undef PG8_LDB
#undef PG8_MMA
#undef PG8_WAIT_V
#undef PG8_WAIT_L
#undef PG8_BAR
#undef PG8_SCHED
}

typedef f32x4 Acc[2][2][4][2];

struct EpiAda {
    static constexpr bool PERM = false, MIDK = false;
    float* MODp; const float* bias;
    __device__ __forceinline__ void operator()(const Acc& acc, const Unit& u, int wr, int wc, int fr, int fq) const {
        const int row0 = wr * 64 + fr, col0 = u.pn * BM + wc * 32 + 4 * fq;
#pragma unroll
        for (int ai = 0; ai < 2; ++ai)
#pragma unroll
            for (int m = 0; m < 4; ++m) { const int r = row0 + ai * HALF + m * 16; if (r < NMODROW) {
#pragma unroll
                for (int bj = 0; bj < 2; ++bj)
#pragma unroll
                    for (int n = 0; n < 2; ++n) { const int c = col0 + bj * HALF + n * 16; *(f32x4*)(MODp + (size_t)r * NMOD + c) = acc[ai][bj][m][n] + *(const f32x4*)(bias + c); } } }
    }
};

struct EpiIn {
    static constexpr bool PERM = true, MIDK = false;
    float* QFK; bf16_t* Z; const float* LB;
    __device__ __forceinline__ void operator()(const Acc& acc, const Unit& u, int wr, int wc, int fr, int fq) const {
        const int row0 = u.pm * BM + wr * 64 + fr, cb = wc * 32 + 8 * fq, pn = u.pn;
        if (pn < 2) {
#pragma unroll
            for (int ai = 0; ai < 2; ++ai)
#pragma unroll
                for (int m = 0; m < 4; ++m) { unsigned char* rp = (unsigned char*)QFK + (size_t)(row0 + ai * HALF + m * 16) * QFKB + QFK_Q + (pn * 256 + cb) * 2;
#pragma unroll
                    for (int bj = 0; bj < 2; ++bj) { const f32x4 v0 = acc[ai][bj][m][0], v1 = acc[ai][bj][m][1];
                        u32x4 w; w.x = cvt_pk_bf16(siluf_(v0[0]), siluf_(v0[1])); w.y = cvt_pk_bf16(siluf_(v0[2]), siluf_(v0[3])); w.z = cvt_pk_bf16(siluf_(v1[0]), siluf_(v1[1])); w.w = cvt_pk_bf16(siluf_(v1[2]), siluf_(v1[3]));
                        *(u32x4*)(rp + bj * HALF * 2) = w; } }
        } else if (pn < 4) {
            const int c0 = (pn - 2) * 256 + cb;
            f32x4 lb[2][2];
#pragma unroll
            for (int bj = 0; bj < 2; ++bj)
#pragma unroll
                for (int n = 0; n < 2; ++n) lb[bj][n] = *(const f32x4*)(LB + c0 + bj * HALF + 4 * n);
#pragma unroll
            for (int ai = 0; ai < 2; ++ai)
#pragma unroll
                for (int m = 0; m < 4; ++m) { unsigned char* rb = (unsigned char*)QFK + (size_t)(row0 + ai * HALF + m * 16) * QFKB;
#pragma unroll
                    for (int bj = 0; bj < 2; ++bj)
#pragma unroll
                        for (int n = 0; n < 2; ++n) { const f32x4 v = acc[ai][bj][m][n]; f32x4 ko;
#pragma unroll
                            for (int e = 0; e < 4; ++e) ko[e] = (1.0f - lb[bj][n][e]) * __builtin_amdgcn_rcpf(1.0f + __expf(v[e]));
                            *(f32x4*)(rb + (c0 + bj * HALF + 4 * n) * 4) = ko; } }
        } else {
            const int zc = (pn - 4) * 256 + cb;
            const int act = (pn < 6) ? 0 : (pn < 8) ? 1 : (pn == 8) ? 0 : (pn < 11) ? 2 : 3;
#pragma unroll
            for (int ai = 0; ai < 2; ++ai)
#pragma unroll
                for (int m = 0; m < 4; ++m) { bf16_t* rp = Z + (size_t)(row0 + ai * HALF + m * 16) * ZC + zc;
#pragma unroll
                    for (int bj = 0; bj < 2; ++bj) { f32x4 v0 = acc[ai][bj][m][0], v1 = acc[ai][bj][m][1];
                        if (act == 1) {
#pragma unroll
                            for (int e = 0; e < 4; ++e) { v0[e] = siluf_(v0[e]); v1[e] = siluf_(v1[e]); }
                        } else if (act == 2) {
#pragma unroll
                            for (int e = 0; e < 4; ++e) { v0[e] = geluf_(v0[e]); v1[e] = geluf_(v1[e]); }
                        } else if (act == 3) {
#pragma unroll
                            for (int e = 0; e < 4; ++e) { v0[e] = sigmoidf_(v0[e]); v1[e] = sigmoidf_(v1[e]); }
                        }
                        u32x4 w; w.x = cvt_pk_bf16(v0[0], v0[1]); w.y = cvt_pk_bf16(v0[2], v0[3]); w.z = cvt_pk_bf16(v1[0], v1[1]); w.w = cvt_pk_bf16(v1[2], v1[3]);
                        *(u32x4*)(rp + bj * HALF) = w; } }
        }
    }
};

struct EpiBranch {
    static constexpr bool PERM = true, MIDK = true;
    bf16_t* Mb; const bf16_t* Z;
    __device__ __forceinline__ void mid(Acc& acc, const Unit& u, int sub, int wr, int wc, int fr, int fq) const {
        const int row0 = u.pm * BM + wr * 64 + fr, col0 = u.pn * BM + wc * 32 + 8 * fq;
#pragma unroll
        for (int ai = 0; ai < 2; ++ai)
#pragma unroll
            for (int m = 0; m < 4; ++m) { const unsigned r = (unsigned)(row0 + ai * HALF + m * 16);
#pragma unroll
                for (int bj = 0; bj < 2; ++bj) { const int c = col0 + bj * HALF;
                    const unsigned bo = (r * ZC + ZGATE + sub * D + c) * 2u;
                    const u32x4 gn = *(const u32x4*)((const char*)Z + bo), gd = *(const u32x4*)((const char*)Z + bo + 2 * D);
                    f32x4& v0 = acc[ai][bj][m][0]; f32x4& v1 = acc[ai][bj][m][1];
                    v0[0] *= bflo(gn.x) * __builtin_amdgcn_rcpf(bflo(gd.x)); v0[1] *= bfhi(gn.x) * __builtin_amdgcn_rcpf(bfhi(gd.x)); v0[2] *= bflo(gn.y) * __builtin_amdgcn_rcpf(bflo(gd.y)); v0[3] *= bfhi(gn.y) * __builtin_amdgcn_rcpf(bfhi(gd.y));
                    v1[0] *= bflo(gn.z) * __builtin_amdgcn_rcpf(bflo(gd.z)); v1[1] *= bfhi(gn.z) * __builtin_amdgcn_rcpf(bfhi(gd.z)); v1[2] *= bflo(gn.w) * __builtin_amdgcn_rcpf(bflo(gd.w)); v1[3] *= bfhi(gn.w) * __builtin_amdgcn_rcpf(bfhi(gd.w)); }
                asm volatile("" ::: "memory"); }
    }
    __device__ __forceinline__ void operator()(const Acc& acc, const Unit& u, int wr, int wc, int fr, int fq) const {
        const int row0 = u.pm * BM + wr * 64 + fr, col0 = u.pn * BM + wc * 32 + 8 * fq;
#pragma unroll
        for (int ai = 0; ai < 2; ++ai)
#pragma unroll
            for (int m = 0; m < 4; ++m) { const unsigned r = (unsigned)(row0 + ai * HALF + m * 16);
#pragma unroll
                for (int bj = 0; bj < 2; ++bj) { const int c = col0 + bj * HALF;
                    const u32x4 gw = *(const u32x4*)((const char*)Z + (r * ZC + ZGATE + 2 * D + c) * 2u);
                    const f32x4 v0 = acc[ai][bj][m][0], v1 = acc[ai][bj][m][1];
                    u32x4 w;
                    w.x = cvt_pk_bf16(bflo(gw.x) * v0[0], bfhi(gw.x) * v0[1]); w.y = cvt_pk_bf16(bflo(gw.y) * v0[2], bfhi(gw.y) * v0[3]);
                    w.z = cvt_pk_bf16(bflo(gw.z) * v1[0], bfhi(gw.z) * v1[1]); w.w = cvt_pk_bf16(bflo(gw.w) * v1[2], bfhi(gw.w) * v1[3]);
                    *(u32x4*)((char*)Mb + (r * D + c) * 2u) = w; }
                asm volatile("" ::: "memory"); }
    }
};

struct EpiRes {
    static constexpr bool PERM = false, MIDK = false;
    float* X; const float* G; const float* XS;
    __device__ __forceinline__ void operator()(const Acc& acc, const Unit& u, int wr, int wc, int fr, int fq) const {
        const int row0 = u.pm * BM + wr * 64 + fr, col0 = u.pn * BM + wc * 32 + 4 * fq;
        const float* gp = G + (size_t)(u.pm >> 3) * NMOD + col0;
        f32x4 gv[2][2];
#pragma unroll
        for (int bj = 0; bj < 2; ++bj)
#pragma unroll
            for (int n = 0; n < 2; ++n) gv[bj][n] = *(const f32x4*)(gp + bj * HALF + n * 16);
#pragma unroll
        for (int ai = 0; ai < 2; ++ai)
#pragma unroll
            for (int m = 0; m < 4; ++m) { const size_t ro = (size_t)(row0 + ai * HALF + m * 16) * D + col0;
#pragma unroll
                for (int bj = 0; bj < 2; ++bj)
#pragma unroll
                    for (int n = 0; n < 2; ++n) { const size_t o = ro + bj * HALF + n * 16; *(f32x4*)(X + o) = *(const f32x4*)(XS + o) + gv[bj][n] * acc[ai][bj][m][n]; } }
    }
};

struct EpiFfn {
    static constexpr bool PERM = true, MIDK = false;
    bf16_t* ACT;
    __device__ __forceinline__ void operator()(const Acc& acc, const Unit& u, int wr, int wc, int fr, int fq) const {
        const int row0 = u.pm * BM + wr * 64 + fr, col0 = u.pn * HALF + wc * 32 + 8 * fq;
#pragma unroll
        for (int ai = 0; ai < 2; ++ai)
#pragma unroll
            for (int m = 0; m < 4; ++m) { bf16_t* rp = ACT + (size_t)(row0 + ai * HALF + m * 16) * FF + col0;
                const f32x4 g0 = acc[ai][0][m][0], g1 = acc[ai][0][m][1], u0 = acc[ai][1][m][0], u1 = acc[ai][1][m][1];
                u32x4 w; w.x = cvt_pk_bf16(siluf_(g0[0]) * u0[0], siluf_(g0[1]) * u0[1]); w.y = cvt_pk_bf16(siluf_(g0[2]) * u0[2], siluf_(g0[3]) * u0[3]);
                w.z = cvt_pk_bf16(siluf_(g1[0]) * u1[0], siluf_(g1[1]) * u1[1]); w.w = cvt_pk_bf16(siluf_(g1[2]) * u1[2], siluf_(g1[3]) * u1[3]);
                *(u32x4*)rp = w; }
    }
};
}

template <class F>
__device__ __forceinline__ void sample_gemm(LAS unsigned char* lds, const bf16_t* A  , int lda, const bf16_t* Bt, int ldb, int kofs, int K, const F& epi) {
    const int tid = TID(), wid = __builtin_amdgcn_readfirstlane(tid >> 6), lane = tid & 63, fr = lane & 15, fq = lane >> 4;
    LAS f32x4* red = (LAS f32x4*)lds;
    const int kw = K / 8;
    for (int it = blockIdx.x; it < 256; it += gridDim.x) {
        const int rb = it >> 6, cbk = it & 63;
        f32x4 a0 = (f32x4){0.f, 0.f, 0.f, 0.f}, a1 = a0;
        const bf16_t* ap = A + (size_t)(rb * 32 + fr) * lda + kofs + wid * kw + 8 * fq;
        const bf16_t* bp = Bt + (size_t)(cbk * 16 + fr) * ldb + kofs + wid * kw + 8 * fq;
        for (int k = 0; k < kw; k += 128) {
            bf16x8 av0[4], av1[4], bv[4];
#pragma unroll
            for (int q = 0; q < 4; ++q) if (k + 32 * q < kw) { av0[q] = *(const bf16x8*)(ap + k + 32 * q); av1[q] = *(const bf16x8*)(ap + (size_t)16 * lda + k + 32 * q); bv[q] = *(const bf16x8*)(bp + k + 32 * q); }
#pragma unroll
            for (int q = 0; q < 4; ++q) if (k + 32 * q < kw) { a0 = __builtin_amdgcn_mfma_f32_16x16x32_bf16(av0[q], bv[q], a0, 0, 0, 0); a1 = __builtin_amdgcn_mfma_f32_16x16x32_bf16(av1[q], bv[q], a1, 0, 0, 0); }
        }
        __syncthreads();
        red[(wid * 2 + 0) * 64 + lane] = a0; red[(wid * 2 + 1) * 64 + lane] = a1;
        __syncthreads();
        if (tid < 128) {
            const int mt = tid >> 6; f32x4 s = (f32x4){0.f, 0.f, 0.f, 0.f};
#pragma unroll
            for (int w = 0; w < 8; ++w) s += red[(w * 2 + mt) * 64 + lane];
            const int col = cbk * 16 + fr, rowb = rb * 32 + mt * 16 + 4 * fq;
#pragma unroll
            for (int i = 0; i < 4; ++i) epi(rowb + i, col, s[i]);
        }
    }
    __syncthreads();
}

struct SampEpiBranch { bf16_t* Mb; const bf16_t* Z; int sub;
    __device__ __forceinline__ void operator()(int r, int c, float v) const { const size_t row = (size_t)(MP + r); const float gt = bf2f(Z[row * ZC + ZGATE + sub * D + c]); const float mo = sub ? bf2f(Mb[row * D + c]) : 0.f;
        Mb[row * D + c] = (bf16_t)(cvt_pk_bf16(mo + gt * v, 0.f) & 0xffffu); } };
struct SampEpiRes { float* X; const float* Gm; const float* XS;
    __device__ __forceinline__ void operator()(int r, int c, float v) const { X[(size_t)(MP + r) * D + c] = XS[(size_t)r * D + c] + Gm[(size_t)(NBP + r) * NMOD + c] * v; } };

__device__ __forceinline__ void sample_gemm_branch(LAS unsigned char* lds, const bf16_t* A, const bf16_t* Bt, bf16_t* Mb, const bf16_t* Z) {
    const int tid = TID(), wid = __builtin_amdgcn_readfirstlane(tid >> 6), lane = tid & 63, fr = lane & 15, fq = lane >> 4;
    LAS f32x4* red = (LAS f32x4*)lds;
    for (int it = blockIdx.x; it < 256; it += gridDim.x) {
        const int rb = it >> 6, cbk = it & 63;
        f32x4 a0 = (f32x4){0.f, 0.f, 0.f, 0.f}, a1 = a0;
        const bf16_t* ap = A + (size_t)(rb * 32 + fr) * D + wid * 128 + 8 * fq;
        const bf16_t* bp = Bt + (size_t)(cbk * 16 + fr) * D + wid * 128 + 8 * fq;
        bf16x8 av0[4], av1[4], bv[4];
#pragma unroll
        for (int q = 0; q < 4; ++q) { av0[q] = *(const bf16x8*)(ap + 32 * q); av1[q] = *(const bf16x8*)(ap + (size_t)16 * D + 32 * q); bv[q] = *(const bf16x8*)(bp + 32 * q); }
        const int mt = tid >> 6, col = cbk * 16 + fr, rowb = rb * 32 + (mt & 1) * 16 + 4 * fq;
        unsigned short gt[4][3];
        if (tid < 128) {
#pragma unroll
            for (int i = 0; i < 4; ++i)
#pragma unroll
                for (int sb = 0; sb < 3; ++sb) gt[i][sb] = Z[(size_t)(MP + rowb + i) * ZC + ZGATE + sb * D + col]; }
#pragma unroll
        for (int q = 0; q < 4; ++q) { a0 = __builtin_amdgcn_mfma_f32_16x16x32_bf16(av0[q], bv[q], a0, 0, 0, 0); a1 = __builtin_amdgcn_mfma_f32_16x16x32_bf16(av1[q], bv[q], a1, 0, 0, 0); }
        __syncthreads();
        red[(wid * 2 + 0) * 64 + lane] = a0; red[(wid * 2 + 1) * 64 + lane] = a1;
        __syncthreads();
        if (tid < 128) {
            const f32x4 ya = (red[(0 * 2 + mt) * 64 + lane] + red[(1 * 2 + mt) * 64 + lane]) + (red[(2 * 2 + mt) * 64 + lane] + red[(3 * 2 + mt) * 64 + lane]);
            const f32x4 yb = red[(4 * 2 + mt) * 64 + lane] + red[(5 * 2 + mt) * 64 + lane];
            const f32x4 yc = red[(6 * 2 + mt) * 64 + lane] + red[(7 * 2 + mt) * 64 + lane];
#pragma unroll
            for (int i = 0; i < 4; ++i) { const float v = bf2f(gt[i][0]) * ya[i] + bf2f(gt[i][1]) * yb[i] + bf2f(gt[i][2]) * yc[i];
                Mb[(size_t)(MP + rowb + i) * D + col] = (bf16_t)(cvt_pk_bf16(v, 0.f) & 0xffffu); }
        }
    }
    __syncthreads();
}

__device__ __forceinline__ void transpose_item(const float* W, int N, bf16_t* WT, int ldt, int k0, int n0, int drow0, LAS float* scr, int lane) {
    float tv[32];
#pragma unroll
    for (int i = 0; i < 32; ++i) { const int kk = 2 * i + (lane >> 5); tv[i] = __builtin_nontemporal_load(W + (size_t)(k0 + kk) * N + n0 + (lane & 31)); }
#pragma unroll
    for (int i = 0; i < 32; ++i) { const int kk = 2 * i + (lane >> 5); scr[kk * 33 + (lane & 31)] = tv[i]; }
    asm volatile("s_waitcnt lgkmcnt(0)" ::: "memory");
    const int c = lane & 7;
#pragma unroll
    for (int j = 0; j < 4; ++j) { const int n = (lane >> 3) + 8 * j; const LAS float* s = scr + (8 * c) * 33 + n;
        u32x4 o; o.x = cvt_pk_bf16(s[0 * 33], s[1 * 33]); o.y = cvt_pk_bf16(s[2 * 33], s[3 * 33]); o.z = cvt_pk_bf16(s[4 * 33], s[5 * 33]); o.w = cvt_pk_bf16(s[6 * 33], s[7 * 33]);
        *(u32x4*)(WT + (size_t)(drow0 + n) * ldt + k0 + 8 * c) = o; }
    asm volatile("s_waitcnt lgkmcnt(0)" ::: "memory");
}

struct Args { const float* in[24]; float* out; unsigned char* ws; int ph_lo, ph_hi; };

__device__ __forceinline__ void prologue(const Args& a, LAS unsigned char* lds) {
    const int tid = TID(), lane = tid & 63, wave = __builtin_amdgcn_readfirstlane(tid >> 6);
    const int G = gridDim.x, gw = blockIdx.x * 8 + wave, NGW = G * 8;
    unsigned char* ws = a.ws;
    LAS float* scr = (LAS float*)(lds + wave * 16384);
    constexpr int I_ADA = 16 * 192, I_IN = 16 * 184, I_BA = 8 * 32, I_BC = 4 * 32, I_O = 16 * 32, I_FI = 16 * 176, I_FO = 44 * 32;
    constexpr int I_L = I_ADA + I_IN + I_BA + I_BC + I_O + I_FI + I_FO;
    for (int it = gw; it < DEPTH * I_L; it += NGW) {
        const int l = it / I_L; int r = it - l * I_L;
        if (r < I_ADA) { const int kb = r / 192, nb = r % 192; transpose_item(INP(6) + (size_t)l * D * NADA, NADA, (bf16_t*)(ws + WS_WADA) + (size_t)l * NADA * D, D, kb * 64, nb * 32, nb * 32, scr, lane); continue; } r -= I_ADA;
        if (r < I_IN) { const int kb = r / 184, nb = r % 184; transpose_item(INP(8) + (size_t)l * D * INC, INC, (bf16_t*)(ws + WS_WIN) + (size_t)l * INC * D, D, kb * 64, nb * 32, nb * 32, scr, lane); continue; } r -= I_IN;
        if (r < I_BA) { const int kb = r / 32, nb = r % 32; transpose_item(INP(17) + (size_t)l * 512 * D, D, (bf16_t*)(ws + WS_WBR) + (size_t)l * D * D, D, kb * 64, nb * 32, nb * 32, scr, lane); continue; } r -= I_BA;
        if (r < I_BC) { const int kb = r / 32, nb = r % 32; transpose_item(INP(19) + (size_t)l * 256 * D, D, (bf16_t*)(ws + WS_WBR) + (size_t)l * D * D + 768, D, kb * 64, nb * 32, nb * 32, scr, lane); continue; } r -= I_BC;
        if (r < I_O) { const int kb = r / 32, nb = r % 32; transpose_item(INP(20) + (size_t)l * D * D, D, (bf16_t*)(ws + WS_WOUT) + (size_t)l * D * D, D, kb * 64, nb * 32, nb * 32, scr, lane); continue; } r -= I_O;
        if (r < I_FI) { const int kb = r / 176, nb = r % 176; const int n0 = nb * 32; const int cc = n0 < FF ? n0 : n0 - FF; const int dr = (cc >> 7) * 256 + (n0 < FF ? 0 : 128) + (cc & 127);
            transpose_item(INP(21) + (size_t)l * D * 2 * FF, 2 * FF, (bf16_t*)(ws + WS_WFI) + (size_t)l * 2 * FF * D, D, kb * 64, n0, dr, scr, lane); continue; } r -= I_FI;
        { const int kb = r / 32, nb = r % 32; transpose_item(INP(22) + (size_t)l * FF * D, D, (bf16_t*)(ws + WS_WFO) + (size_t)l * D * FF, FF, kb * 64, nb * 32, nb * 32, scr, lane); }
    }
    for (int it = gw; it < DEPTH * 4 * 16 * 8; it += NGW) {
        const int l = it >> 9, g = (it >> 7) & 3, nblk = (it >> 3) & 15, c8 = it & 7, n = nblk * 64 + lane;
        const float* mp = INP(11) + ((size_t)(l * 4 + g) * 64 + c8 * 8) * 64; const float* sc = INP(12) + l * 256 + g * 64; const float* wb = INP(18) + ((size_t)l * 256 + g * 64) * D + n;
        float acc[8];
#pragma unroll
        for (int j = 0; j < 8; ++j) acc[j] = 0.f;
        for (int d0 = 0; d0 < 64; d0 += 16) { float wv[16];
#pragma unroll
            for (int dd = 0; dd < 16; ++dd) wv[dd] = wb[(size_t)(d0 + dd) * D];
#pragma unroll
            for (int dd = 0; dd < 16; ++dd) { const float w = wv[dd] * sc[d0 + dd];
#pragma unroll
                for (int j = 0; j < 8; ++j) acc[j] += mp[j * 64 + d0 + dd] * w; } }
        u32x4 o; o.x = cvt_pk_bf16(acc[0], acc[1]); o.y = cvt_pk_bf16(acc[2], acc[3]); o.z = cvt_pk_bf16(acc[4], acc[5]); o.w = cvt_pk_bf16(acc[6], acc[7]);
        *(u32x4*)((bf16_t*)(ws + WS_WBR) + (size_t)l * D * D + (size_t)n * D + 512 + g * 64 + c8 * 8) = o;
    }
    { bf16_t* Wc = (bf16_t*)(ws + WS_CWS); const float* src = INP(15);
      for (int i = blockIdx.x * 512 + tid; i < DEPTH * 4 * 128 * 128 / 4; i += G * 512) { const int e = i * 4, t = (e >> 7) & 127, s0 = e & 127; const f32x4 v = *(const f32x4*)(src + e);
          u32x2 o; o.x = cvt_pk_bf16(s0 <= t ? v[0] : 0.f, s0 + 1 <= t ? v[1] : 0.f); o.y = cvt_pk_bf16(s0 + 2 <= t ? v[2] : 0.f, s0 + 3 <= t ? v[3] : 0.f); *(u32x2*)(Wc + e) = o; } }
    { bf16_t* C = (bf16_t*)(ws + WS_COND);
      for (int i = blockIdx.x * 512 + tid; i < 256 * D / 4; i += G * 512) { const int row = i >> 8, c4 = (i & 255) * 4; f32x4 v = (f32x4){0.f, 0.f, 0.f, 0.f};
          if (row < NBP) v = *(const f32x4*)(INP(4) + (size_t)row * D + c4); else if (row < NMODROW) v = *(const f32x4*)(INP(5) + (size_t)(row - NBP) * D + c4);
          u32x2 o; o.x = cvt_pk_bf16(siluf_(v[0]), siluf_(v[1])); o.y = cvt_pk_bf16(siluf_(v[2]), siluf_(v[3])); *(u32x2*)(C + (size_t)row * D + c4) = o; } }
    if (blockIdx.x == 0) { float* LB = (float*)(ws + WS_LB); const float* lg = INP(9); const int k = tid;
        const float x0 = lg[k], x1 = lg[512 + k], x2 = lg[1024 + k], x3 = lg[1536 + k]; const float mx = fmaxf(fmaxf(x0, x1), fmaxf(x2, x3));
        const float e0 = expf(x0 - mx), e1 = expf(x1 - mx), e2 = expf(x2 - mx), e3 = expf(x3 - mx), inv = 1.0f / (e0 + e1 + e2 + e3);
        LB[k] = 0.f; LB[512 + k] = fmaxf(e1 * inv, 0.f); LB[1024 + k] = fmaxf((e1 + e2) * inv, 0.f); LB[1536 + k] = fmaxf((e1 + e2 + e3) * inv, 0.f); }
}

__device__ __forceinline__ void norm_phase(const Args& a, int l, int which, bool first) {
    const int tid_ = TID(), lane = tid_ & 63, wave = tid_ >> 6, gw = blockIdx.x * 8 + wave, NGW = gridDim.x * 8;
    float* X = a.out; bf16_t* H = (bf16_t*)(a.ws + WS_H); const float* MODp = (const float*)(a.ws + WS_MOD) + l * NADA + which * 3 * D;
    const float* xp = INP(0); const float* xs = INP(1);
    for (int rb = gw; rb < MV; rb += 4 * NGW) {
        f32x4 v[4][4]; float s[4];
#pragma unroll
        for (int q = 0; q < 4; ++q) { const int r = rb + q * NGW; s[q] = 0.f;
            if (r < MV) { const float* xr = first ? (r < MP ? xp + (size_t)r * D : xs + (size_t)(r - MP) * D) : X + (size_t)r * D;
#pragma unroll
                for (int j = 0; j < 4; ++j) v[q][j] = *(const f32x4*)(xr + 4 * lane + 256 * j); }
            else {
#pragma unroll
                for (int j = 0; j < 4; ++j) v[q][j] = (f32x4){0.f, 0.f, 0.f, 0.f}; } }
#pragma unroll
        for (int q = 0; q < 4; ++q)
#pragma unroll
            for (int j = 0; j < 4; ++j) s[q] += (v[q][j][0] * v[q][j][0] + v[q][j][1] * v[q][j][1]) + (v[q][j][2] * v[q][j][2] + v[q][j][3] * v[q][j][3]);
#pragma unroll
        for (int o = 1; o < 64; o <<= 1) {
#pragma unroll
            for (int q = 0; q < 4; ++q) s[q] += __shfl_xor(s[q], o); }
#pragma unroll
        for (int q = 0; q < 4; ++q) { const int r = rb + q * NGW; if (r < MV) {
            const float rstd = rsqrtf(s[q] * (1.0f / D) + 1e-6f);
            const float* mr = MODp + (size_t)mod_row(r) * NMOD;
#pragma unroll
            for (int j = 0; j < 4; ++j) { const int c = 4 * lane + 256 * j; const f32x4 sh = *(const f32x4*)(mr + c), sc = *(const f32x4*)(mr + D + c); const f32x4 o = v[q][j] * rstd * (sc + 1.0f) + sh;
                u32x2 w; w.x = cvt_pk_bf16(o[0], o[1]); w.y = cvt_pk_bf16(o[2], o[3]); *(u32x2*)(H + (size_t)r * D + c) = w; } } }
    }
}
__device__ __forceinline__ void final_phase(const Args& a) {
    const int tid_ = TID(), lane = tid_ & 63, wave = tid_ >> 6, gw = blockIdx.x * 8 + wave, NGW = gridDim.x * 8;
    float* X = a.out; const float* fg = INP(23);
    f32x4 fgv[4];
#pragma unroll
    for (int j = 0; j < 4; ++j) fgv[j] = *(const f32x4*)(fg + 4 * lane + 256 * j);
    for (int rb = gw; rb < MV; rb += 4 * NGW) {
        f32x4 v[4][4]; float s[4];
#pragma unroll
        for (int q = 0; q < 4; ++q) { const int r = rb + q * NGW; s[q] = 0.f;
#pragma unroll
            for (int j = 0; j < 4; ++j) v[q][j] = (r < MV) ? *(const f32x4*)(X + (size_t)r * D + 4 * lane + 256 * j) : (f32x4){0.f, 0.f, 0.f, 0.f}; }
#pragma unroll
        for (int q = 0; q < 4; ++q)
#pragma unroll
            for (int j = 0; j < 4; ++j) s[q] += (v[q][j][0] * v[q][j][0] + v[q][j][1] * v[q][j][1]) + (v[q][j][2] * v[q][j][2] + v[q][j][3] * v[q][j][3]);
#pragma unroll
        for (int o = 1; o < 64; o <<= 1) {
#pragma unroll
            for (int q = 0; q < 4; ++q) s[q] += __shfl_xor(s[q], o); }
#pragma unroll
        for (int q = 0; q < 4; ++q) { const int r = rb + q * NGW; if (r < MV) { const float rstd = rsqrtf(s[q] * (1.0f / D) + 1e-6f);
#pragma unroll
            for (int j = 0; j < 4; ++j) *(f32x4*)(X + (size_t)r * D + 4 * lane + 256 * j) = v[q][j] * rstd * fgv[j]; } }
    }
}

typedef __bf16 bf16x2_t __attribute__((ext_vector_type(2)));
__device__ __forceinline__ unsigned cvtpk(float lo, float hi) { f32x2 v = {lo, hi}; bf16x2_t b = __builtin_convertvector(v, bf16x2_t); return __builtin_bit_cast(unsigned, b); }
constexpr int HQ_P = 136, HK_P = 24, HO_P = 132;
template <bool PASS3>
__device__ __forceinline__ void hgrn_unit(const Args& a, LAS unsigned char* lds, int l, int b, int h, int j) {
    const int tid = TID(), lane = tid & 63, w = __builtin_amdgcn_readfirstlane(tid >> 6), c16 = lane & 15, g = lane >> 4;
    LAS bf16_t* QT = (LAS bf16_t*)lds;
    LAS bf16_t* KT = QT + 16 * HQ_P;
    LAS bf16_t* KH = KT + 16 * HQ_P;
    LAS bf16_t* VT = KH + 128 * HK_P;
    LAS float* DD = (LAS float*)(VT + 128 * HK_P);
    LAS float* TOT = DD + 128;
    LAS float* OB = TOT + 512;
    const float* QFK = (const float*)(a.ws + WS_QFK); const bf16_t* Z = (const bf16_t*)(a.ws + WS_Z);
    float* U = (float*)(a.ws + WS_U); float* DU = (float*)(a.ws + WS_DU);
    const int bh = b * 4 + h, t0 = b * SEQ + j * SPAN;
    const int pk = tid & 127, tq = tid >> 7;
    f32x4 S[8];
#pragma unroll
    for (int kt = 0; kt < 8; ++kt) S[kt] = (f32x4){0.f, 0.f, 0.f, 0.f};
    if (PASS3) {
        for (int jj = 0; jj < j; ++jj) { const float* up = U + (size_t)(bh * NSPAN + jj) * 16384 + (size_t)w * 2048 + lane * 4; const float* dp = DU + (size_t)(bh * NSPAN + jj) * 128;
#pragma unroll
            for (int kt = 0; kt < 8; ++kt) { const f32x4 dd = *(const f32x4*)(dp + 16 * kt + 4 * g);
                S[kt] = dd * S[kt] + *(const f32x4*)(up + kt * 256); } }
    }
    float bsum = 0.f;
    float rfA[2][4], rqA[2][4], rkA[2][4]; unsigned rvA[2][4];
#pragma unroll
    for (int pp = 0; pp < 2; ++pp)
#pragma unroll
        for (int i = 0; i < 4; ++i) { const size_t row = (size_t)(t0 + pp * 16 + 4 * tq + i); const unsigned char* bp = (const unsigned char*)QFK + row * QFKB; if (PASS3) rqA[pp][i] = bf2f(*(const bf16_t*)(bp + QFK_Q + (h * 128 + pk) * 2)); rkA[pp][i] = *(const float*)(bp + (h * 128 + pk) * 4); rfA[pp][i] = fmaxf(1.0f - rkA[pp][i], 1e-30f); rvA[pp][i] = Z[row * ZC + ZV + h * 128 + pk]; }
    const int tt_n = tid >> 5, c4_n = (tid & 31) * 4;
    f32x4 gn = (f32x4){0.f, 0.f, 0.f, 0.f};
    if (PASS3) gn = *(const f32x4*)(INP(10) + (size_t)l * 512 + h * 128 + c4_n);
    for (int blk2 = 0; blk2 < SPAN / 32; ++blk2)
#pragma unroll
    for (int par = 0; par < 2; ++par) {
        const int blk = 2 * blk2 + par;
        float (&rf)[4] = rfA[par]; float (&rq)[4] = rqA[par]; float (&rk)[4] = rkA[par]; unsigned (&rv)[4] = rvA[par];
        u32x2 gg = (u32x2){0u, 0u};
        if (PASS3) gg = *(const u32x2*)(Z + (size_t)(t0 + blk * 16 + tt_n) * ZC + ZG + h * 128 + c4_n);
        float p[4]; { float acc = 0.f;
#pragma unroll
            for (int i = 0; i < 4; ++i) { acc += __logf(rf[i]); p[i] = acc; } }
        TOT[tq * 128 + pk] = p[3];
        LDS_BAR();
        {
            const float t0_ = TOT[pk], t1_ = TOT[128 + pk], t2_ = TOT[256 + pk], t3_ = TOT[384 + pk];
            const float off = tq == 0 ? 0.f : tq == 1 ? t0_ : tq == 2 ? t0_ + t1_ : (t0_ + t1_) + t2_;
            const float b15 = (t0_ + t1_) + (t2_ + t3_);
            float kh[4];
#pragma unroll
            for (int i = 0; i < 4; ++i) { const float bb = off + p[i]; const int t = 4 * tq + i;
                if (PASS3) { const float e = __expf(bb); QT[t * HQ_P + pk] = (bf16_t)(cvtpk(rq[i] * e, 0.f) & 0xffffu); KT[t * HQ_P + pk] = (bf16_t)(cvtpk(rk[i] * __expf(-bb), 0.f) & 0xffffu); }
                kh[i] = rk[i] * __expf(b15 - bb); }
            *(LAS u32x2*)(KH + pk * HK_P + 4 * tq) = (u32x2){cvtpk(kh[0], kh[1]), cvtpk(kh[2], kh[3])};
            *(LAS u32x2*)(VT + pk * HK_P + 4 * tq) = (u32x2){rv[0] | (rv[1] << 16), rv[2] | (rv[3] << 16)};
            if (tq == 0) { DD[pk] = __expf(b15); bsum += b15; }
        }
        if (blk + 2 < SPAN / 16) {
#pragma unroll
            for (int i = 0; i < 4; ++i) { const size_t row = (size_t)(t0 + (blk + 2) * 16 + 4 * tq + i); const unsigned char* bp = (const unsigned char*)QFK + row * QFKB; if (PASS3) rq[i] = bf2f(*(const bf16_t*)(bp + QFK_Q + (h * 128 + pk) * 2)); rk[i] = *(const float*)(bp + (h * 128 + pk) * 4); rf[i] = fmaxf(1.0f - rk[i], 1e-30f); rv[i] = Z[row * ZC + ZV + h * 128 + pk]; }
        }
        LDS_BAR();
        {
            const bf16x8 zero8 = (bf16x8){0, 0, 0, 0, 0, 0, 0, 0};
            if (PASS3) {
                f32x4 oT = (f32x4){0.f, 0.f, 0.f, 0.f}, AT = (f32x4){0.f, 0.f, 0.f, 0.f};
#pragma unroll
                for (int s2 = 0; s2 < 4; ++s2) {
                    const u32x4 aw = (u32x4){cvtpk(S[2 * s2][0], S[2 * s2][1]), cvtpk(S[2 * s2][2], S[2 * s2][3]), cvtpk(S[2 * s2 + 1][0], S[2 * s2 + 1][1]), cvtpk(S[2 * s2 + 1][2], S[2 * s2 + 1][3])};
                    const u32x2 q0 = *(const LAS u32x2*)(QT + c16 * HQ_P + 32 * s2 + 4 * g), q1 = *(const LAS u32x2*)(QT + c16 * HQ_P + 32 * s2 + 16 + 4 * g);
                    const u32x4 bw = (u32x4){q0.x, q0.y, q1.x, q1.y};
                    oT = __builtin_amdgcn_mfma_f32_16x16x32_bf16(__builtin_bit_cast(bf16x8, aw), __builtin_bit_cast(bf16x8, bw), oT, 0, 0, 0);
                    const bf16x8 ka = *(const LAS bf16x8*)(KT + c16 * HQ_P + 32 * s2 + 8 * g), qb = *(const LAS bf16x8*)(QT + c16 * HQ_P + 32 * s2 + 8 * g);
                    AT = __builtin_amdgcn_mfma_f32_16x16x32_bf16(ka, qb, AT, 0, 0, 0);
                }
#pragma unroll
                for (int i = 0; i < 4; ++i) AT[i] = (4 * g + i <= c16) ? AT[i] : 0.f;
                const u32x4 atw = (u32x4){cvtpk(AT[0], AT[1]), cvtpk(AT[2], AT[3]), 0u, 0u};
                const u32x2 vv = *(const LAS u32x2*)(VT + (16 * w + c16) * HK_P + 4 * g);
                const u32x4 vw = (u32x4){vv.x, vv.y, 0u, 0u};
                oT = __builtin_amdgcn_mfma_f32_16x16x32_bf16(__builtin_bit_cast(bf16x8, vw), __builtin_bit_cast(bf16x8, atw), oT, 0, 0, 0);
                *(LAS f32x4*)(OB + c16 * HO_P + 16 * w + 4 * g) = oT;
            }
            bf16x8 vb = zero8; if (g < 2) vb = *(const LAS bf16x8*)(VT + (16 * w + c16) * HK_P + 8 * g);
#pragma unroll
            for (int kt = 0; kt < 8; ++kt) {
                bf16x8 ka = zero8; if (g < 2) ka = *(const LAS bf16x8*)(KH + (16 * kt + c16) * HK_P + 8 * g);
                const f32x4 dd = *(const LAS f32x4*)(DD + 16 * kt + 4 * g);
                S[kt] = __builtin_amdgcn_mfma_f32_16x16x32_bf16(ka, vb, S[kt] * dd, 0, 0, 0);
            }
        }
        LDS_BAR();
        if (PASS3) {
            const int tt = tid >> 5, c4 = (tid & 31) * 4;
            const f32x4 o = *(const LAS f32x4*)(OB + tt * HO_P + c4);
            float ss = (o[0] * o[0] + o[1] * o[1]) + (o[2] * o[2] + o[3] * o[3]);
#pragma unroll
            for (int m = 1; m < 32; m <<= 1) ss += __shfl_xor(ss, m);
            const float rstd = rsqrtf(ss * (1.0f / 128.0f) + 1e-6f);
            const size_t row = (size_t)(t0 + blk * 16 + tt);
            u32x2 wv; wv.x = cvtpk(o[0] * rstd * gn[0] * bflo(gg.x), o[1] * rstd * gn[1] * bfhi(gg.x)); wv.y = cvtpk(o[2] * rstd * gn[2] * bflo(gg.y), o[3] * rstd * gn[3] * bfhi(gg.y));
            *(u32x2*)((bf16_t*)(a.ws + WS_MIX) + row * D + h * 128 + c4) = wv;
        }
    }
    if (!PASS3) {
        float* up = U + (size_t)(bh * NSPAN + j) * 16384 + (size_t)w * 2048 + lane * 4;
#pragma unroll
        for (int kt = 0; kt < 8; ++kt) *(f32x4*)(up + kt * 256) = S[kt];
        if (tq == 0) DU[(size_t)(bh * NSPAN + j) * 128 + pk] = __expf(bsum);
    } else if (j == NSPAN - 1) {
        float* hp = a.out + O_HP + ((size_t)(l * NBP + b) * 4 + h) * 16384 + 16 * w + c16;
#pragma unroll
        for (int kt = 0; kt < 8; ++kt)
#pragma unroll
            for (int i = 0; i < 4; ++i) hp[(size_t)(16 * kt + 4 * g + i) * 128] = S[kt][i];
    }
    __syncthreads();
}

__device__ __forceinline__ void hgrn_sample_unit(const Args& a, LAS unsigned char* lds, int l, int b, int h) {
    const int tid = TID(), v = tid & 127, kq = tid >> 7;
    LAS float* red = (LAS float*)lds;
    const size_t row = (size_t)(MP + b);
    const unsigned char* qb_ = (const unsigned char*)(a.ws + WS_QFK) + row * QFKB; const float* qF = (const float*)qb_ + h * 128; const bf16_t* qQ = (const bf16_t*)(qb_ + QFK_Q) + h * 128; const bf16_t* Z = (const bf16_t*)(a.ws + WS_Z) + row * ZC;
    const float vv = bf2f(Z[ZV + h * 128 + v]);
    const float* sp = INP(2) + (((size_t)l * MS + b) * 4 + h) * 16384 + (size_t)(kq * 32) * 128 + v;
    float* so = a.out + O_HS + (((size_t)l * MS + b) * 4 + h) * 16384 + (size_t)(kq * 32) * 128 + v;
    float o = 0.f;
    float sv[32];
#pragma unroll
    for (int i = 0; i < 32; ++i) sv[i] = __builtin_nontemporal_load(sp + (size_t)i * 128);
#pragma unroll
    for (int i = 0; i < 32; ++i) { const int k = kq * 32 + i; const float kk_ = qF[k]; const float s = (1.0f - kk_) * sv[i] + kk_ * vv; __builtin_nontemporal_store(s, so + (size_t)i * 128); o += bf2f(qQ[k]) * s; }
    __syncthreads();
    red[kq * 128 + v] = o;
    __syncthreads();
    if (tid < 128) {
        const float ot = (red[v] + red[128 + v]) + (red[256 + v] + red[384 + v]);
        float ss = wave_sum(ot * ot);
        red[512 + (tid >> 6)] = ss;
    }
    __syncthreads();
    if (tid < 128) {
        const float ot = (red[v] + red[128 + v]) + (red[256 + v] + red[384 + v]);
        const float rstd = rsqrtf((red[512] + red[513]) * (1.0f / 128.0f) + 1e-6f);
        const float val = ot * rstd * INP(10)[(size_t)l * 512 + h * 128 + v] * bf2f(Z[ZG + h * 128 + v]);
        ((bf16_t*)(a.ws + WS_MIX))[row * D + h * 128 + v] = (bf16_t)(cvt_pk_bf16(val, 0.f) & 0xffffu);
    }
    __syncthreads();
}

__device__ __forceinline__ void pool_phase(const Args& a, int l) {
    const int gt = blockIdx.x * 512 + TID(), NT = gridDim.x * 512;
    const bf16_t* Z = (const bf16_t*)(a.ws + WS_Z); bf16_t* MIX = (bf16_t*)(a.ws + WS_MIX);
    for (int it = gt; it < MP * 32; it += NT) {
        const int r = it >> 5, c8 = (it & 31) * 8, t = r & (SEQ - 1), wnd = 2 << (c8 >> 6);
        const int n = (t + 1 < wnd) ? t + 1 : wnd;
        float s[8];
#pragma unroll
        for (int q = 0; q < 8; ++q) s[q] = 0.f;
        u32x4 cur = *(const u32x4*)(Z + (size_t)r * ZC + ZP + c8);
        u32x4 pv[15];
#pragma unroll
        for (int i = 1; i < 16; ++i) pv[i - 1] = (i < n) ? *(const u32x4*)(Z + (size_t)(r - i) * ZC + ZP + c8) : (u32x4){0u, 0u, 0u, 0u};
#pragma unroll
        for (int i = 0; i < 15; ++i) { const u32x4 p = pv[i];
            s[0] += bflo(p.x); s[1] += bfhi(p.x); s[2] += bflo(p.y); s[3] += bfhi(p.y); s[4] += bflo(p.z); s[5] += bfhi(p.z); s[6] += bflo(p.w); s[7] += bfhi(p.w); }
        const float x[8] = {bflo(cur.x), bfhi(cur.x), bflo(cur.y), bfhi(cur.y), bflo(cur.z), bfhi(cur.z), bflo(cur.w), bfhi(cur.w)};
        const float inv = 1.0f / (float)n; float z[8];
#pragma unroll
        for (int q = 0; q < 8; ++q) z[q] = (s[q] + x[q]) * inv - x[q];
        u32x4 o; o.x = cvt_pk_bf16(z[0], z[1]); o.y = cvt_pk_bf16(z[2], z[3]); o.z = cvt_pk_bf16(z[4], z[5]); o.w = cvt_pk_bf16(z[6], z[7]);
        *(u32x4*)(MIX + (size_t)r * D + 512 + c8) = o;
    }
    for (int it = gt; it < MS * 256; it += NT) {
        const int b = it >> 8, c = it & 255, wnd = 2 << (c >> 6);
        const float* st = INP(3) + ((size_t)l * MS + b) * 15 * 256 + c;
        const float x = bf2f(Z[(size_t)(MP + b) * ZC + ZP + c]);
        float stv[15];
#pragma unroll
        for (int i = 0; i < 15; ++i) stv[i] = st[(size_t)i * 256];
        float s = x;
#pragma unroll
        for (int i = 1; i < 16; ++i) s += (i < wnd) ? stv[15 - i] : 0.f;
        const float z = s / (float)wnd - x;
        MIX[(size_t)(MP + b) * D + 512 + c] = (bf16_t)(cvt_pk_bf16(z, 0.f) & 0xffffu);
        float* ps = a.out + O_PS + ((size_t)l * MS + b) * 15 * 256 + c;
#pragma unroll
        for (int i = 0; i < 14; ++i) ps[(size_t)i * 256] = stv[i + 1];
        ps[(size_t)14 * 256] = x;
    }
    for (int it = gt; it < NBP * 15 * 256; it += NT) {
        const int b = it / (15 * 256), rem = it - b * 15 * 256, i = rem >> 8, c = rem & 255;
        a.out[O_PP + ((size_t)l * NBP + b) * 15 * 256 + rem] = bf2f(Z[(size_t)(b * SEQ + SEQ - 15 + i) * ZC + ZP + c]);
    }
}

constexpr int GV_P = 136;
__device__ __forceinline__ void gating_unit(const Args& a, LAS unsigned char* lds, int l, int unit) {
    const int tid = TID(), lane = tid & 63, w = __builtin_amdgcn_readfirstlane(tid >> 6), c16 = lane & 15, g4 = lane >> 4;
    const int g = unit & 3, ch = (unit >> 2) & 15, b = unit >> 6, r0 = b * SEQ + ch * 128;
    LAS bf16_t* vnT = (LAS bf16_t*)lds;
    const bf16_t* Z = (const bf16_t*)(a.ws + WS_Z); bf16_t* MIX = (bf16_t*)(a.ws + WS_MIX);
    const float* lg = INP(13) + l * 256, * lbb = INP(14) + l * 256;
    __syncthreads();
    {
        const int c = 4 * lane; const bool mine = (lane >> 4) == g;
        const f32x4 gg = *(const f32x4*)(lg + c), bb = *(const f32x4*)(lbb + c);
        u32x2 pall[16];
#pragma unroll
        for (int i = 0; i < 16; ++i) pall[i] = *(const u32x2*)(Z + (size_t)(r0 + 16 * w + i) * ZC + ZVC + c);
#pragma unroll
        for (int q = 0; q < 4; ++q) {
            u32x2 p[4];
#pragma unroll
            for (int i = 0; i < 4; ++i) p[i] = pall[4 * q + i];
            float x[4][4], sm[4];
#pragma unroll
            for (int i = 0; i < 4; ++i) { x[i][0] = bflo(p[i].x); x[i][1] = bfhi(p[i].x); x[i][2] = bflo(p[i].y); x[i][3] = bfhi(p[i].y); sm[i] = (x[i][0] + x[i][1]) + (x[i][2] + x[i][3]); }
#pragma unroll
            for (int o = 1; o < 64; o <<= 1) {
#pragma unroll
                for (int i = 0; i < 4; ++i) sm[i] += __shfl_xor(sm[i], o); }
            float sq[4];
#pragma unroll
            for (int i = 0; i < 4; ++i) { const float mu = sm[i] * (1.0f / 256.0f);
#pragma unroll
                for (int e = 0; e < 4; ++e) x[i][e] -= mu;
                sq[i] = (x[i][0] * x[i][0] + x[i][1] * x[i][1]) + (x[i][2] * x[i][2] + x[i][3] * x[i][3]); }
#pragma unroll
            for (int o = 1; o < 64; o <<= 1) {
#pragma unroll
                for (int i = 0; i < 4; ++i) sq[i] += __shfl_xor(sq[i], o); }
            if (mine) {
#pragma unroll
                for (int i = 0; i < 4; ++i) { const float rstd = rsqrtf(sq[i] * (1.0f / 256.0f) + 1e-6f); const int sidx = 16 * w + 4 * q + i;
#pragma unroll
                    for (int e = 0; e < 4; ++e) vnT[((c & 63) + e) * GV_P + sidx] = (bf16_t)(cvt_pk_bf16(x[i][e] * rstd * gg[e] + bb[e], 0.f) & 0xffffu); }
            }
        }
    }
    __syncthreads();
    {
        const bf16_t* Wb = (const bf16_t*)(a.ws + WS_CWS) + (size_t)(l * 4 + g) * 16384 + (size_t)(16 * w + c16) * 128 + 8 * g4;
        const int nks = (w >> 1) + 1;
        bf16x8 af[4];
#pragma unroll
        for (int ks = 0; ks < 4; ++ks) af[ks] = (ks < nks) ? *(const bf16x8*)(Wb + 32 * ks) : (bf16x8){0, 0, 0, 0, 0, 0, 0, 0};
        const float* bs = INP(16) + (size_t)(l * 4 + g) * 128 + 16 * w + 4 * g4;
        const f32x4 bsv = *(const f32x4*)bs;
        unsigned short uu_[4][4];
#pragma unroll
        for (int ct = 0; ct < 4; ++ct)
#pragma unroll
            for (int i = 0; i < 4; ++i) uu_[ct][i] = Z[(size_t)(r0 + 16 * w + 4 * g4 + i) * ZC + ZU + g * 64 + 16 * ct + c16];
#pragma unroll
        for (int ct = 0; ct < 4; ++ct) {
            f32x4 acc = (f32x4){0.f, 0.f, 0.f, 0.f};
#pragma unroll
            for (int ks = 0; ks < 4; ++ks) if (ks < nks) { const bf16x8 bf = *(const LAS bf16x8*)(vnT + (16 * ct + c16) * GV_P + 32 * ks + 8 * g4); acc = __builtin_amdgcn_mfma_f32_16x16x32_bf16(af[ks], bf, acc, 0, 0, 0); }
#pragma unroll
            for (int i = 0; i < 4; ++i) { const size_t row = (size_t)(r0 + 16 * w + 4 * g4 + i); const int cc = g * 64 + 16 * ct + c16;
                const float uu = bf2f(uu_[ct][i]);
                MIX[row * D + 768 + cc] = (bf16_t)(cvt_pk_bf16(uu * (acc[i] + bsv[i]), 0.f) & 0xffffu); }
        }
    }
}
__device__ __forceinline__ void gating_sample(const Args& a, int l) {
    const int tid_ = TID(), lane = tid_ & 63, gw = blockIdx.x * 8 + (tid_ >> 6), NGW = gridDim.x * 8;
    const bf16_t* Z = (const bf16_t*)(a.ws + WS_Z); bf16_t* MIX = (bf16_t*)(a.ws + WS_MIX);
    for (int b = gw; b < MS; b += NGW) {
        const size_t row = (size_t)(MP + b);
        const u32x2 p = *(const u32x2*)(Z + row * ZC + ZVC + 4 * lane);
        const float x0 = bflo(p.x), x1 = bfhi(p.x), x2 = bflo(p.y), x3 = bfhi(p.y);
        const float mu = wave_sum((x0 + x1) + (x2 + x3)) * (1.0f / 256.0f);
        const float d0 = x0 - mu, d1 = x1 - mu, d2 = x2 - mu, d3 = x3 - mu;
        const float rstd = rsqrtf(wave_sum((d0 * d0 + d1 * d1) + (d2 * d2 + d3 * d3)) * (1.0f / 256.0f) + 1e-6f);
        const int c = 4 * lane, g = lane >> 4;
        const f32x4 gg = *(const f32x4*)(INP(13) + l * 256 + c), bb = *(const f32x4*)(INP(14) + l * 256 + c);
        const f32x4 vn = (f32x4){d0 * rstd * gg[0] + bb[0], d1 * rstd * gg[1] + bb[1], d2 * rstd * gg[2] + bb[2], d3 * rstd * gg[3] + bb[3]};
        *(f32x4*)(a.out + O_CV + ((size_t)l * MS + b) * 256 + c) = vn;
        const float w00 = INP(15)[(size_t)(l * 4 + g) * 16384], b0 = INP(16)[(size_t)(l * 4 + g) * 128];
        const u32x2 up = *(const u32x2*)(Z + row * ZC + ZU + c);
        u32x2 o; o.x = cvt_pk_bf16(bflo(up.x) * (w00 * vn[0] + b0), bfhi(up.x) * (w00 * vn[1] + b0)); o.y = cvt_pk_bf16(bflo(up.y) * (w00 * vn[2] + b0), bfhi(up.y) * (w00 * vn[3] + b0));
        *(u32x2*)(MIX + row * D + 768 + c) = o;
    }
}

#define XB_TMO      128
#define XB_XCNT(j)  (256  + 64 * (j))
#define XB_XSUB(j)  (1280 + 64 * (j))
#define XB_XGEN(j)  (2304 + 64 * (j))
#define XB_TOP      3328
#define XB_TOPGEN   3392
#define XCD_BAR_WORDS 3456
#define XB_SPIN_CAP (1u << 18)

__device__ __forceinline__ unsigned xb_ld(unsigned* p)              { return __hip_atomic_load(p, __ATOMIC_RELAXED, __HIP_MEMORY_SCOPE_AGENT); }
__device__ __forceinline__ unsigned xb_add(unsigned* p, unsigned v) { return __hip_atomic_fetch_add(p, v, __ATOMIC_RELAXED, __HIP_MEMORY_SCOPE_AGENT); }
__device__ __forceinline__ unsigned xb_xcc_id() { return (unsigned)__builtin_amdgcn_s_getreg((3 << 11) | 20) & 0xFu; }
#define XB_SPIN(cond, bar) do { unsigned _sp = 0; while (cond) { __builtin_amdgcn_s_sleep(1); \
    if ((++_sp & 255u) == 0u) { if (xb_ld(&(bar)[XB_TMO])) break; if (_sp > XB_SPIN_CAP) { atomicAdd(&(bar)[XB_TMO], 1u); break; } } } } while (0)

struct XcdBarrier {
    unsigned* bar; unsigned x;
    volatile LAS unsigned* st;
};

__device__ __forceinline__ XcdBarrier xcd_barrier_post(unsigned* bar, volatile LAS unsigned* st) {
    XcdBarrier b; b.bar = bar; b.x = xb_xcc_id(); b.st = st;
    if (threadIdx.x == 0) (void)xb_add(&bar[XB_XCNT(b.x)], 1u);
    return b;
}
__device__ __forceinline__ void xcd_barrier_complete(unsigned* bar, unsigned x, unsigned& nloc, unsigned& nx) {
    const unsigned G = gridDim.x * gridDim.y * gridDim.z;
    unsigned sum, cnt, mine, sp = 0u;
    for (;;) {
        sum = 0u; cnt = 0u; mine = 0u;
#pragma unroll
        for (unsigned j = 0; j < 16; ++j) { const unsigned c = xb_ld(&bar[XB_XCNT(j)]); sum += c; cnt += (c > 0u) ? 1u : 0u; mine = (j == x) ? c : mine; }
        if (sum == G) break;
        __builtin_amdgcn_s_sleep(1);
        if ((++sp & 255u) == 0u) { if (xb_ld(&bar[XB_TMO])) break; if (sp > XB_SPIN_CAP) { atomicAdd(&bar[XB_TMO], 1u); break; } }
    }
    nloc = mine > 0u ? mine : 1u; nx = cnt > 0u ? cnt : 1u;
}

__device__ __forceinline__ void xcd_barrier(const XcdBarrier& b) {
    asm volatile("s_waitcnt vmcnt(0)" ::: "memory");
    __syncthreads();
    if (threadIdx.x == 0) {
        unsigned* bar = b.bar;
        __builtin_amdgcn_s_waitcnt(0);
        unsigned nloc = b.st[0], nx = b.st[1];
        if (nloc == 0u) { xcd_barrier_complete(bar, b.x, nloc, nx); b.st[0] = nloc; b.st[1] = nx; }
        const unsigned old = xb_add(&bar[XB_XSUB(b.x)], 1u);
        const unsigned gen = old / nloc;
        if (old + 1u == (gen + 1u) * nloc) {
            __builtin_amdgcn_fence(__ATOMIC_RELEASE, "agent");
            asm volatile("s_waitcnt vmcnt(0)" ::: "memory");
            const unsigned og = xb_add(&bar[XB_TOP], 1u);
            const unsigned tg = og / nx;
            if (og + 1u == (tg + 1u) * nx) xb_add(&bar[XB_TOPGEN], 1u);
            else XB_SPIN(xb_ld(&bar[XB_TOPGEN]) == tg, bar);
            __builtin_amdgcn_fence(__ATOMIC_ACQUIRE, "agent");
            xb_add(&bar[XB_XGEN(b.x)], 1u);
            asm volatile("s_waitcnt vmcnt(0)" ::: "memory");
        } else {
            XB_SPIN(xb_ld(&bar[XB_XGEN(b.x)]) == gen, bar);
            __builtin_amdgcn_fence(__ATOMIC_ACQUIRE, "agent");
            asm volatile("s_waitcnt vmcnt(0)" ::: "memory");
        }
    }
    __syncthreads();
}

constexpr int NSUB = 10;
constexpr int N_PHASES = 2 + NSUB * DEPTH + 1;
#ifndef ENMASK
#define ENMASK 0xffff
#endif
#define EN(k) (((ENMASK) >> (k)) & 1)
__global__ void __launch_bounds__(512, 2) fwd_kernel(Args a) {
    extern __shared__ __attribute__((aligned(16))) unsigned char lds_raw[];
    LAS unsigned char* lds = (LAS unsigned char*)lds_raw;
    cg::grid_group grid = cg::this_grid();
    if (threadIdx.x == 0) { LAS unsigned long long* tb = (LAS unsigned long long*)(lds + PTR_TBL_OFF);
#define PT_(k) tb[k] = (unsigned long long)a.in[k];
        PT_(0) PT_(1) PT_(2) PT_(3) PT_(4) PT_(5) PT_(6) PT_(7) PT_(8) PT_(9) PT_(10) PT_(11) PT_(12) PT_(13) PT_(14) PT_(15) PT_(16) PT_(17) PT_(18) PT_(19) PT_(20) PT_(21) PT_(22) PT_(23)
#undef PT_
    }
    volatile LAS unsigned* bst = (volatile LAS unsigned*)(lds + 131072 + 512);
    if (threadIdx.x < 2) bst[threadIdx.x] = 0u;
    __syncthreads();
    XcdBarrier xbar = xcd_barrier_post((unsigned*)(a.ws + WS_CTL), bst);
#if defined(REPMASK)
    int rep_ = 0;
#endif
    for (int ph = a.ph_lo; ph < a.ph_hi; ++ph) {
        unsigned char* ws = a.ws; int G = gridDim.x, bx = blockIdx.x;
        asm volatile("" : "+s"(ws), "+s"(G), "+s"(bx));
#if defined(REPMASK)
        const int s__ = (ph - 2) % NSUB; const int ty_ = ph == 0 ? 0 : ph == 1 ? 1 : ph == N_PHASES - 1 ? 2 : (s__ == 0 || s__ == 7) ? 3 : (s__ == 1 || s__ == 4) ? 4 : s__ == 2 ? 5 : s__ == 3 ? 6 : s__ == 5 ? 7 : s__ == 8 ? 9 : 8;
#endif
        if (ph == 0) { if (EN(0)) prologue(a, lds); }
        else if (ph == 1 && EN(1)) {
            pg8::Gemm g{(const bf16_t*)(ws + WS_COND), (const bf16_t*)(ws + WS_WADA), D, D}; pg8::Order<1> S; S.init(1, NMOD / 256, G, bx, 0, D / 64);
            pg8::EpiAda E{(float*)(ws + WS_MOD), INP(7)};
            pg8::gemm_phase<pg8::EpiAda, true, 1>(lds, g, S, E);
        } else if (ph == N_PHASES - 1) { if (EN(2)) final_phase(a); }
        else if (ph == 1) {}
        else {
            const int l = (ph - 2) / NSUB, s = (ph - 2) % NSUB;
            if (s == 0) { if (EN(3)) norm_phase(a, l, 0, l == 0); }
            else if ((s == 1 || s == 4) && EN(4)) {
                pg8::Gemm g{(const bf16_t*)(ws + WS_H), (const bf16_t*)(ws + WS_WIN) + (size_t)l * INC * D, D, D}; pg8::Order<1> S;
                if (s == 1) S.init(MP / 256, 11, G, bx, INC / 256, D / 64); else { S.init(MP / 256, 12, G, bx, 0, D / 64); S.pofs = 11; }
                pg8::EpiIn E{(float*)(ws + WS_QFK), (bf16_t*)(ws + WS_Z), (const float*)(ws + WS_LB) + l * 512};
                pg8::gemm_phase<pg8::EpiIn, true, 1>(lds, g, S, E);
            } else if (s == 2 && EN(5)) {
#ifndef REPA
#define REPA 0
#endif
                for (int rp = 0; rp <= ((REPA >> 0) & 1); ++rp)
                for (int u = bx; u < NBP * 4 * (NSPAN - 1); u += G) { const int bh = u / (NSPAN - 1), j = u % (NSPAN - 1); hgrn_unit<false>(a, lds, l, bh >> 2, bh & 3, j); }
                for (int rp = 0; rp <= ((REPA >> 1) & 1); ++rp)
                pool_phase(a, l);
                for (int rp = 0; rp <= ((REPA >> 2) & 1); ++rp)
                for (int u = G - 1 - bx; u < NBP * 16 * 4; u += G) gating_unit(a, lds, l, u);
                gating_sample(a, l);
                __syncthreads();
                for (int rp = 0; rp <= ((REPA >> 3) & 1); ++rp)
                for (int u = G - 1 - bx; u < MS * 4; u += G) hgrn_sample_unit(a, lds, l, u >> 2, u & 3);
            } else if (s == 3 && EN(6)) {
                for (int u = bx; u < NBP * 4 * NSPAN; u += G) { const int bh = u >> 3, j = u & 7; hgrn_unit<true>(a, lds, l, bh >> 2, bh & 3, j); }
            } else if (s == 5 && EN(7)) {
                pg8::Gemm g{(const bf16_t*)(ws + WS_MIX), (const bf16_t*)(ws + WS_WBR) + (size_t)l * D * D, D, D}; pg8::Order<1> S; S.init(MP / 256, D / 256, G, bx, 0, D / 64);
                bf16_t* Mb = (bf16_t*)(ws + WS_H); const bf16_t* Z = (const bf16_t*)(ws + WS_Z);
                pg8::EpiBranch E{Mb, Z};
                pg8::gemm_phase<pg8::EpiBranch, true, 1>(lds, g, S, E);
                sample_gemm_branch(lds, g.A + (size_t)MP * D, g.Bt, Mb, Z);
            } else if ((s == 6 || s == 9) && EN(8)) {
                const bool ff = (s == 9);
                const float* Gm = (const float*)(ws + WS_MOD) + l * NADA + (ff ? 5 : 2) * D;
                pg8::Gemm g; if (ff) g = pg8::Gemm{(const bf16_t*)(ws + WS_Z), (const bf16_t*)(ws + WS_WFO) + (size_t)l * D * FF, FF, FF}; else g = pg8::Gemm{(const bf16_t*)(ws + WS_H), (const bf16_t*)(ws + WS_WOUT) + (size_t)l * D * D, D, D};
                pg8::Order<1> S; S.init(MP / 256, D / 256, G, bx, 0, ff ? FF / 64 : D / 64);
                const bool src_in = (!ff && l == 0);
                pg8::EpiRes E{a.out, Gm, src_in ? INP(0) : a.out};
                pg8::gemm_phase<pg8::EpiRes, true, 1>(lds, g, S, E);
                SampEpiRes epi{a.out, Gm, src_in ? INP(1) : a.out + (size_t)MP * D};
                sample_gemm(lds, g.A + (size_t)MP * g.lda, g.lda, g.Bt, g.ldb, 0, ff ? FF : D, epi);
            } else if (s == 7) { if (EN(3)) norm_phase(a, l, 1, false); }
            else if (s == 8 && EN(9)) {
                pg8::Gemm g{(const bf16_t*)(ws + WS_H), (const bf16_t*)(ws + WS_WFI) + (size_t)l * 2 * FF * D, D, D}; pg8::Order<1> S; S.init(MP / 256, 2 * FF / 256, G, bx, 2 * FF / 256, D / 64);
                pg8::EpiFfn E{(bf16_t*)(ws + WS_Z)};
                pg8::gemm_phase<pg8::EpiFfn, true, 1>(lds, g, S, E);
            }
        }
        if (ph >= 2 && (ph - 2) % NSUB == 3) continue;
        if (ph + 1 < a.ph_hi) { if (ph == 0) grid.sync(); else xcd_barrier(xbar); }
#if defined(REPMASK)
        if (((REPMASK) >> ty_) & 1) { if (!rep_) { rep_ = 1; --ph; } else rep_ = 0; }
#endif
    }
}

#ifndef ONE_LAUNCH
#define ONE_LAUNCH 1
#endif
extern "C" void kernel_launch(void* const* d_in, const int* in_sizes, int n_in, void* d_out, int out_size, void* d_ws, size_t ws_size, hipStream_t stream) {
    static int grid = 0;
    if (grid == 0) {
        if (n_in != 24 || ws_size < WS_END) { fprintf(stderr, "kernel_launch: unexpected n_in %d or ws_size %zu (< %zu)\n", n_in, ws_size, (size_t)WS_END); grid = -1; return; }
        int dev = 0, cus = 0, per_cu = 0;
        hipGetDevice(&dev); hipDeviceGetAttribute(&cus, hipDeviceAttributeMultiprocessorCount, dev);
        if (hipFuncSetAttribute((const void*)fwd_kernel, hipFuncAttributeMaxDynamicSharedMemorySize, LDS_BYTES) != hipSuccess) { fprintf(stderr, "kernel_launch: hipFuncSetAttribute failed\n"); grid = -1; return; }
        if (hipOccupancyMaxActiveBlocksPerMultiprocessor(&per_cu, (const void*)fwd_kernel, 512, LDS_BYTES) != hipSuccess || per_cu < 1) { fprintf(stderr, "kernel_launch: occupancy query failed (%d)\n", per_cu); (void)hipGetLastError(); per_cu = 1; }
        grid = cus * (per_cu > 1 ? 1 : per_cu);
        fprintf(stderr, "kernel_launch: grid %d (cus %d, per_cu %d)\n", grid, cus, per_cu);
    }
    if (grid < 0) return;
    if (hipMemsetAsync((char*)d_ws + WS_CTL, 0, CTL_BYTES, stream) != hipSuccess) { fprintf(stderr, "kernel_launch: memset failed\n"); return; }
    Args a{};
    for (int i = 0; i < 24; ++i) a.in[i] = (const float*)d_in[i];
    a.out = (float*)d_out; a.ws = (unsigned char*)d_ws;
#if ONE_LAUNCH
    a.ph_lo = 0; a.ph_hi = N_PHASES;
    void* args[] = {&a};
    hipError_t e = hipLaunchCooperativeKernel((const void*)fwd_kernel, dim3(grid), dim3(512), args, LDS_BYTES, stream);
    if (e != hipSuccess) fprintf(stderr, "cooperative launch failed: %s (grid %d)\n", hipGetErrorString(e), grid);
#else
    for (int ph = 0; ph < N_PHASES; ++ph) {
        a.ph_lo = ph; a.ph_hi = ph + 1;
        hipLaunchKernelGGL(fwd_kernel, dim3(grid), dim3(512), LDS_BYTES, stream, a);
    }
#endif
}
```

```cpp
#include <hip/hip_runtime.h>
#include <hip/hip_cooperative_groups.h>
#include <cstdio>
#include <cstdint>
namespace cg = cooperative_groups;

#define LAS __attribute__((address_space(3)))
typedef unsigned short bf16_t;
typedef short bf16x8 __attribute__((ext_vector_type(8)));
typedef float f32x4 __attribute__((ext_vector_type(4)));
typedef float f32x2 __attribute__((ext_vector_type(2)));
typedef unsigned u32x4 __attribute__((ext_vector_type(4)));
typedef unsigned u32x2 __attribute__((ext_vector_type(2)));

constexpr int D = 1024, NBP = 8, SEQ = 2048, MP = NBP * SEQ, MS = 128, MV = MP + MS, MPAD = 16640, DEPTH = 4;
constexpr int INC = 5888, ZC = 4864, FF = 2816, NADA = 6 * D, NMOD = DEPTH * NADA, NMODROW = NBP + MS;
constexpr int ZV = 0, ZG = 512, ZP = 1024, ZU = 1280, ZVC = 1536, ZGATE = 1792;
constexpr int QFKC = 1536;
constexpr int QFKB = 3072, QFK_Q = 2048;
constexpr int NSPAN = 8, SPAN = SEQ / NSPAN;
constexpr size_t MiB = 1u << 20;
constexpr size_t WS_WADA = 0;
constexpr size_t WS_MIX = 0;
constexpr size_t WS_WIN = 48 * MiB;
constexpr size_t WS_WBR = 94 * MiB;
constexpr size_t WS_WOUT = 102 * MiB;
constexpr size_t WS_WFI = 110 * MiB;
constexpr size_t WS_WFO = 154 * MiB;
constexpr size_t WS_COND = 176 * MiB;
constexpr size_t WS_LB = 176 * MiB + 512 * 1024;
constexpr size_t WS_MOD = 177 * MiB;
constexpr size_t WS_H = 190 * MiB;
constexpr size_t WS_Z = 223 * MiB;
constexpr size_t WS_QFK = 378 * MiB;
constexpr size_t WS_U = 476 * MiB;
constexpr size_t WS_DU = 492 * MiB;
constexpr size_t WS_CTL = 493 * MiB;
constexpr size_t CTL_BYTES = 16384;
constexpr size_t WS_CWS = 493 * MiB + 65536;
constexpr size_t WS_END = 494 * MiB;
constexpr size_t O_Y = 0, O_HP = (size_t)MV * D, O_PP = O_HP + (size_t)DEPTH * NBP * 4 * 16384, O_HS = O_PP + (size_t)DEPTH * NBP * 15 * 256,
                 O_PS = O_HS + (size_t)DEPTH * MS * 4 * 16384, O_CV = O_PS + (size_t)DEPTH * MS * 15 * 256;
constexpr int LDS_BYTES = 147456;

__device__ __forceinline__ unsigned cvt_pk_bf16(float lo, float hi) { unsigned r; asm volatile("v_cvt_pk_bf16_f32 %0, %1, %2" : "=v"(r) : "v"(lo), "v"(hi)); return r; }
__device__ __forceinline__ float bf2f(unsigned h) { return __uint_as_float(h << 16); }
__device__ __forceinline__ float bflo(unsigned w) { return __uint_as_float(w << 16); }
__device__ __forceinline__ float bfhi(unsigned w) { return __uint_as_float(w & 0xffff0000u); }
__device__ __forceinline__ float sigmoidf_(float x) { return __builtin_amdgcn_rcpf(1.0f + __expf(-x)); }
__device__ __forceinline__ float siluf_(float x) { return x * sigmoidf_(x); }
__device__ __forceinline__ float geluf_(float x) { const float y = 1.5957691216057308f * (x + 0.044715f * x * x * x); return x * sigmoidf_(y); }
__device__ __forceinline__ float wave_sum(float v) {
#pragma unroll
    for (int o = 1; o < 64; o <<= 1) v += __shfl_xor(v, o);
    return v;
}
__device__ __forceinline__ int TID() { int t = threadIdx.x; asm volatile("" : "+v"(t)); return t; }
constexpr int PTR_TBL_OFF = 131072 + 1024;
__device__ __forceinline__ const float* INP(int k) {
    extern __shared__ __attribute__((aligned(16))) unsigned char lds_raw_[];
    const LAS unsigned* t = (const LAS unsigned*)((LAS unsigned char*)lds_raw_ + PTR_TBL_OFF) + 2 * k;
    const unsigned lo = __builtin_amdgcn_readfirstlane(t[0]), hi = __builtin_amdgcn_readfirstlane(t[1]);
    return (const float*)(((unsigned long long)hi << 32) | lo);
}
#define LDS_BAR() do { asm volatile("s_waitcnt lgkmcnt(0)" ::: "memory"); __builtin_amdgcn_s_barrier(); asm volatile("" ::: "memory"); } while (0)
__device__ __forceinline__ int mod_row(int r) { return r < MP ? (r >> 11) : (NBP + r - MP); }

namespace pg8 {
constexpr int BM = 256, BK = 64, HALF = 128, HTB = HALF * BK * 2, STAGE_BYTES = 8 * HTB, NXCD = 8, WGM = 8;
__host__ __device__ __forceinline__ int lds_byte(int r, int c) { const int st = (r >> 4) * 2 + (c >> 5), rr = r & 15, cc = c & 31, ob = rr * 64 + cc * 2; return st * 1024 + (ob ^ (((ob >> 9) & 1) << 5)); }
__host__ __device__ __forceinline__ void stage_rc(int b, int& R, int& C) { const int st = b / 1024, sb = b % 1024, swz = sb ^ (((sb >> 9) & 1) << 5); R = (st >> 1) * 16 + swz / 64; C = (st & 1) * 32 + (swz % 64) / 2; }
__host__ __device__ __forceinline__ int perm32(int rho) { const int n = rho >> 4, i = rho & 15; return 8 * (i >> 2) + 4 * n + (i & 3); }

struct Unit { int pm, pn, kofs, nt, sub; };
struct Gemm { const bf16_t* A; const bf16_t* Bt; int lda, ldb; };

template <int SUBS>
struct Order {
    int nM, nN, nwg, G, c, extra, nt0, pofs;
    __device__ void init(int nM_, int nN_, int G_, int c_, int extra_, int nt) { nM = nM_; nN = nN_; nwg = nM * nN; G = G_; c = c_; extra = extra_; nt0 = nt; pofs = 0; }
    __device__ bool next(int i, Unit& u) const {
        const int round = i / SUBS, sub = i - round * SUBS;
        const long L = (long)round * G + c;
        if (L >= nwg + extra) return false;
        u.sub = sub;
        if (SUBS == 3) { u.kofs = sub == 0 ? 0 : 256 + 256 * sub; u.nt = sub == 0 ? 8 : 4; } else { u.kofs = 0; u.nt = nt0; }
        if (L >= nwg) { u.pm = nM; u.pn = (int)(L - nwg); return true; }
        int wgid = (int)L; { const int q = nwg / NXCD, r = nwg % NXCD, xcd = wgid % NXCD, off = wgid / NXCD; wgid = (xcd < r ? xcd * (q + 1) : r * (q + 1) + (xcd - r) * q) + off; }
        const int nig = WGM * nN, gid = wgid / nig, fm = gid * WGM, gsz = (nM - fm) < WGM ? (nM - fm) : WGM;
        u.pm = fm + ((wgid % nig) % gsz); u.pn = pofs + (wgid % nig) / gsz; return true;
    }
};

template <class Epi, bool ALIGN_EPI, int SUBS>
__device__ __forceinline__ void gemm_phase(LAS unsigned char* lds, const Gemm g, const Order<SUBS>& S, const Epi& E) {
    const int tid = TID(), wid = __builtin_amdgcn_readfirstlane(tid >> 6), lane = tid & 63, wr = wid >> 2, wc = wid & 3, fr = lane & 15, fq = lane >> 4;
    unsigned voffA[2], voffB[2];
#pragma unroll
    for (int i = 0; i < 2; ++i) { int R, C; stage_rc(tid * 16 + i * 8192, R, C); const int Rb = Epi::PERM ? ((R & ~31) + perm32(R & 31)) : R;
        voffA[i] = (unsigned)(R * g.lda + C) * 2u; voffB[i] = (unsigned)(Rb * g.ldb + C) * 2u; }
    const size_t kstep = (size_t)(BK * 2);
    const size_t hstepA = (size_t)HALF * g.lda * 2, hstepB = (size_t)HALF * g.ldb * 2;
    const unsigned ldsw = (unsigned)wid * 1024u;
    const int aoff = lds_byte(wr * 64 + fr, fq * 8), boff = lds_byte(wc * 32 + fr, fq * 8);
#define PG8_SA(b, h) (((b) * 2 + (h)) * HTB)
#define PG8_SB(b, h) ((4 + (b) * 2 + (h)) * HTB)
#define PG8_STAGE(bufoff, gbase, voff) do { _Pragma("unroll") for (int _i = 0; _i < 2; ++_i) \
        __builtin_amdgcn_global_load_lds((const unsigned*)((const char*)(gbase) + (voff)[_i]), (LAS unsigned*)(lds + (bufoff) + ldsw + _i * 8192), 16, 0, 0); } while (0)
#define PG8_LDA(dst, b, h) do { _Pragma("unroll") for (int m = 0; m < 4; ++m) _Pragma("unroll") for (int k = 0; k < 2; ++k) dst[m][k] = *(const LAS bf16x8*)(lds + PG8_SA(b, h) + aoff + m * 2048 + k * 1024); } while (0)
#define PG8_LDB(dst, b, h) do { _Pragma("unroll") for (int n = 0; n < 2; ++n) _Pragma("unroll") for (int k = 0; k < 2; ++k) dst[n][k] = *(const LAS bf16x8*)(lds + PG8_SB(b, h) + boff + n * 2048 + k * 1024); } while (0)
#define PG8_MMA(ai, bj, At, Bt) do { __builtin_amdgcn_s_setprio(1); _Pragma("unroll") for (int m = 0; m < 4; ++m) _Pragma("unroll") for (int n = 0; n < 2; ++n) _Pragma("unroll") for (int k = 0; k < 2; ++k) \
        acc[ai][bj][m][n] = __builtin_amdgcn_mfma_f32_16x16x32_bf16(Bt[n][k], At[m][k], acc[ai][bj][m][n], 0, 0, 0); __builtin_amdgcn_s_setprio(0); } while (0)
#define PG8_WAIT_V(n) asm volatile("s_waitcnt vmcnt(" #n ")" ::: "memory")
#define PG8_WAIT_L(n) asm volatile("s_waitcnt lgkmcnt(" #n ")" ::: "memory")
#define PG8_BAR __builtin_amdgcn_s_barrier()
#define PG8_SCHED __builtin_amdgcn_sched_barrier(0)
    Unit cur, nxt; int ui = 0;
    if (!S.next(0, cur)) return;
    f32x4 acc[2][2][4][2];
#pragma unroll
    for (int a = 0; a < 2; ++a)
#pragma unroll
        for (int b = 0; b < 2; ++b)
#pragma unroll
            for (int m = 0; m < 4; ++m)
#pragma unroll
                for (int n = 0; n < 2; ++n) acc[a][b][m][n] = (f32x4){0.f, 0.f, 0.f, 0.f};
    bf16x8 At[4][2], B0[2][2], B1[2][2];
    const char* cA = (const char*)g.A + (size_t)cur.pm * 2 * hstepA + (size_t)cur.kofs * 2; const char* cB = (const char*)g.Bt + (size_t)cur.pn * 2 * hstepB + (size_t)cur.kofs * 2;
    PG8_STAGE(PG8_SB(0, 0), cB, voffB); PG8_STAGE(PG8_SB(0, 1), cB + hstepB, voffB); PG8_STAGE(PG8_SA(0, 0), cA, voffA); PG8_STAGE(PG8_SA(0, 1), cA + hstepA, voffA);
    if (wr == 1) PG8_BAR;
    PG8_WAIT_V(2); PG8_BAR;
    PG8_STAGE(PG8_SB(1, 0), cB + kstep, voffB); PG8_STAGE(PG8_SA(1, 0), cA + kstep, voffA); PG8_STAGE(PG8_SB(1, 1), cB + hstepB + kstep, voffB);
    PG8_WAIT_V(6); PG8_BAR;
    for (;;) {
        const bool has_next = S.next(ui + 1, nxt);
        const char* nA = has_next ? (const char*)g.A + (size_t)nxt.pm * 2 * hstepA + (size_t)nxt.kofs * 2 : cA; const char* nB = has_next ? (const char*)g.Bt + (size_t)nxt.pn * 2 * hstepB + (size_t)nxt.kofs * 2 : cB;
        const int nt = cur.nt;
        for (int t = 0; t < nt; t += 2) {
            if constexpr (Epi::MIDK) { if (t == 8 || t == 12) E.mid(acc, cur, t == 8 ? 0 : 1, wr, wc, fr, fq); }
            const bool last = (t == nt - 2);
            const char* a1 = cA + (size_t)(t + 1) * kstep;
            const char* a2 = last ? nA : cA + (size_t)(t + 2) * kstep; const char* b2 = last ? nB : cB + (size_t)(t + 2) * kstep;
            const char* a3 = a2 + kstep; const char* b3 = b2 + kstep;
            PG8_LDB(B0, 0, 0); PG8_LDB(B1, 0, 1); PG8_SCHED; PG8_LDA(At, 0, 0); PG8_STAGE(PG8_SA(1, 1), a1 + hstepA, voffA);
            PG8_WAIT_V(8); PG8_WAIT_L(0); PG8_BAR; PG8_MMA(0, 0, At, B0); PG8_MMA(0, 1, At, B1); PG8_BAR; PG8_SCHED;
            PG8_LDA(At, 0, 1); PG8_STAGE(PG8_SB(0, 0), b2, voffB); PG8_STAGE(PG8_SB(0, 1), b2 + hstepB, voffB); PG8_STAGE(PG8_SA(0, 0), a2, voffA);
            PG8_WAIT_V(8); PG8_WAIT_L(0); PG8_BAR; PG8_MMA(1, 0, At, B0); PG8_MMA(1, 1, At, B1); PG8_BAR; PG8_SCHED;
            PG8_LDB(B0, 1, 0); PG8_LDB(B1, 1, 1); PG8_SCHED; PG8_LDA(At, 1, 0); PG8_STAGE(PG8_SA(0, 1), a2 + hstepA, voffA);
            PG8_WAIT_V(8); PG8_WAIT_L(0); PG8_BAR; PG8_MMA(0, 0, At, B0); PG8_MMA(0, 1, At, B1); PG8_BAR; PG8_SCHED;
            PG8_LDA(At, 1, 1); PG8_STAGE(PG8_SB(1, 0), b3, voffB); PG8_STAGE(PG8_SB(1, 1), b3 + hstepB, voffB); PG8_STAGE(PG8_SA(1, 0), a3, voffA);
            PG8_WAIT_V(8); PG8_WAIT_L(0); PG8_BAR; PG8_MMA(1, 0, At, B0); PG8_MMA(1, 1, At, B1); PG8_BAR; PG8_SCHED;
        }
        if constexpr (ALIGN_EPI) { if (wr == 0) PG8_BAR; }
        E(acc, cur, wr, wc, fr, fq);
        if (!has_next) break;
#pragma unroll
        for (int a = 0; a < 2; ++a)
#pragma unroll
            for (int b = 0; b < 2; ++b)
#pragma unroll
                for (int m = 0; m < 4; ++m)
#pragma unroll
                    for (int n = 0; n < 2; ++n) acc[a][b][m][n] = (f32x4){0.f, 0.f, 0.f, 0.f};
        cur = nxt; cA = nA; cB = nB; ++ui;
        if constexpr (ALIGN_EPI) { if (wr == 1) PG8_BAR; }
    }
    PG8_WAIT_V(0);
    if constexpr (!ALIGN_EPI) { if (wr == 0) PG8_BAR; }
    PG8_BAR;
#undef PG8_SA
#undef PG8_SB
#undef PG8_STAGE
#undef PG8_LDA
#undef PG8_LDB
#undef PG8_MMA
#undef PG8_WAIT_V
#undef PG8_WAIT_L
#undef PG8_BAR
#undef PG8_SCHED
}

typedef f32x4 Acc[2][2][4][2];

struct EpiAda {
    static constexpr bool PERM = false, MIDK = false;
    float* MODp; const float* bias;
    __device__ __forceinline__ void operator()(const Acc& acc, const Unit& u, int wr, int wc, int fr, int fq) const {
        const int row0 = wr * 64 + fr, col0 = u.pn * BM + wc * 32 + 4 * fq;
#pragma unroll
        for (int ai = 0; ai < 2; ++ai)
#pragma unroll
            for (int m = 0; m < 4; ++m) { const int r = row0 + ai * HALF + m * 16; if (r < NMODROW) {
#pragma unroll
                for (int bj = 0; bj < 2; ++bj)
#pragma unroll
                    for (int n = 0; n < 2; ++n) { const int c = col0 + bj * HALF + n * 16; *(f32x4*)(MODp + (size_t)r * NMOD + c) = acc[ai][bj][m][n] + *(const f32x4*)(bias + c); } } }
    }
};

struct EpiIn {
    static constexpr bool PERM = true, MIDK = false;
    float* QFK; bf16_t* Z; const float* LB;
    __device__ __forceinline__ void operator()(const Acc& acc, const Unit& u, int wr, int wc, int fr, int fq) const {
        const int row0 = u.pm * BM + wr * 64 + fr, cb = wc * 32 + 8 * fq, pn = u.pn;
        if (pn < 2) {
#pragma unroll
            for (int ai = 0; ai < 2; ++ai)
#pragma unroll
                for (int m = 0; m < 4; ++m) { unsigned char* rp = (unsigned char*)QFK + (size_t)(row0 + ai * HALF + m * 16) * QFKB + QFK_Q + (pn * 256 + cb) * 2;
#pragma unroll
                    for (int bj = 0; bj < 2; ++bj) { const f32x4 v0 = acc[ai][bj][m][0], v1 = acc[ai][bj][m][1];
                        u32x4 w; w.x = cvt_pk_bf16(siluf_(v0[0]), siluf_(v0[1])); w.y = cvt_pk_bf16(siluf_(v0[2]), siluf_(v0[3])); w.z = cvt_pk_bf16(siluf_(v1[0]), siluf_(v1[1])); w.w = cvt_pk_bf16(siluf_(v1[2]), siluf_(v1[3]));
                        *(u32x4*)(rp + bj * HALF * 2) = w; } }
        } else if (pn < 4) {
            const int c0 = (pn - 2) * 256 + cb;
            f32x4 lb[2][2];
#pragma unroll
            for (int bj = 0; bj < 2; ++bj)
#pragma unroll
                for (int n = 0; n < 2; ++n) lb[bj][n] = *(const f32x4*)(LB + c0 + bj * HALF + 4 * n);
#pragma unroll
            for (int ai = 0; ai < 2; ++ai)
#pragma unroll
                for (int m = 0; m < 4; ++m) { unsigned char* rb = (unsigned char*)QFK + (size_t)(row0 + ai * HALF + m * 16) * QFKB;
#pragma unroll
                    for (int bj = 0; bj < 2; ++bj)
#pragma unroll
                        for (int n = 0; n < 2; ++n) { const f32x4 v = acc[ai][bj][m][n]; f32x4 ko;
#pragma unroll
                            for (int e = 0; e < 4; ++e) ko[e] = (1.0f - lb[bj][n][e]) * __builtin_amdgcn_rcpf(1.0f + __expf(v[e]));
                            *(f32x4*)(rb + (c0 + bj * HALF + 4 * n) * 4) = ko; } }
        } else {
            const int zc = (pn - 4) * 256 + cb;
            const int act = (pn < 6) ? 0 : (pn < 8) ? 1 : (pn == 8) ? 0 : (pn < 11) ? 2 : 3;
#pragma unroll
            for (int ai = 0; ai < 2; ++ai)
#pragma unroll
                for (int m = 0; m < 4; ++m) { bf16_t* rp = Z + (size_t)(row0 + ai * HALF + m * 16) * ZC + zc;
#pragma unroll
                    for (int bj = 0; bj < 2; ++bj) { f32x4 v0 = acc[ai][bj][m][0], v1 = acc[ai][bj][m][1];
                        if (act == 1) {
#pragma unroll
                            for (int e = 0; e < 4; ++e) { v0[e] = siluf_(v0[e]); v1[e] = siluf_(v1[e]); }
                        } else if (act == 2) {
#pragma unroll
                            for (int e = 0; e < 4; ++e) { v0[e] = geluf_(v0[e]); v1[e] = geluf_(v1[e]); }
                        } else if (act == 3) {
#pragma unroll
                            for (int e = 0; e < 4; ++e) { v0[e] = sigmoidf_(v0[e]); v1[e] = sigmoidf_(v1[e]); }
                        }
                        u32x4 w; w.x = cvt_pk_bf16(v0[0], v0[1]); w.y = cvt_pk_bf16(v0[2], v0[3]); w.z = cvt_pk_bf16(v1[0], v1[1]); w.w = cvt_pk_bf16(v1[2], v1[3]);
                        *(u32x4*)(rp + bj * HALF) = w; } }
        }
    }
};

struct EpiBranch {
    static constexpr bool PERM = true, MIDK = true;
    bf16_t* Mb; const bf16_t* Z;
    __device__ __forceinline__ void mid(Acc& acc, const Unit& u, int sub, int wr, int wc, int fr, int fq) const {
        const int row0 = u.pm * BM + wr * 64 + fr, col0 = u.pn * BM + wc * 32 + 8 * fq;
#pragma unroll
        for (int ai = 0; ai < 2; ++ai)
#pragma unroll
            for (int m = 0; m < 4; ++m) { const unsigned r = (unsigned)(row0 + ai * HALF + m * 16);
#pragma unroll
                for (int bj = 0; bj < 2; ++bj) { const int c = col0 + bj * HALF;
                    const unsigned bo = (r * ZC + ZGATE + sub * D + c) * 2u;
                    const u32x4 gn = *(const u32x4*)((const char*)Z + bo), gd = *(const u32x4*)((const char*)Z + bo + 2 * D);
                    f32x4& v0 = acc[ai][bj][m][0]; f32x4& v1 = acc[ai][bj][m][1];
                    v0[0] *= bflo(gn.x) * __builtin_amdgcn_rcpf(bflo(gd.x)); v0[1] *= bfhi(gn.x) * __builtin_amdgcn_rcpf(bfhi(gd.x)); v0[2] *= bflo(gn.y) * __builtin_amdgcn_rcpf(bflo(gd.y)); v0[3] *= bfhi(gn.y) * __builtin_amdgcn_rcpf(bfhi(gd.y));
                    v1[0] *= bflo(gn.z) * __builtin_amdgcn_rcpf(bflo(gd.z)); v1[1] *= bfhi(gn.z) * __builtin_amdgcn_rcpf(bfhi(gd.z)); v1[2] *= bflo(gn.w) * __builtin_amdgcn_rcpf(bflo(gd.w)); v1[3] *= bfhi(gn.w) * __builtin_amdgcn_rcpf(bfhi(gd.w)); }
                asm volatile("" ::: "memory"); }
    }
    __device__ __forceinline__ void operator()(const Acc& acc, const Unit& u, int wr, int wc, int fr, int fq) const {
        const int row0 = u.pm * BM + wr * 64 + fr, col0 = u.pn * BM + wc * 32 + 8 * fq;
#pragma unroll
        for (int ai = 0; ai < 2; ++ai)
#pragma unroll
            for (int m = 0; m < 4; ++m) { const unsigned r = (unsigned)(row0 + ai * HALF + m * 16);
#pragma unroll
                for (int bj = 0; bj < 2; ++bj) { const int c = col0 + bj * HALF;
                    const u32x4 gw = *(const u32x4*)((const char*)Z + (r * ZC + ZGATE + 2 * D + c) * 2u);
                    const f32x4 v0 = acc[ai][bj][m][0], v1 = acc[ai][bj][m][1];
                    u32x4 w;
                    w.x = cvt_pk_bf16(bflo(gw.x) * v0[0], bfhi(gw.x) * v0[1]); w.y = cvt_pk_bf16(bflo(gw.y) * v0[2], bfhi(gw.y) * v0[3]);
                    w.z = cvt_pk_bf16(bflo(gw.z) * v1[0], bfhi(gw.z) * v1[1]); w.w = cvt_pk_bf16(bflo(gw.w) * v1[2], bfhi(gw.w) * v1[3]);
                    *(u32x4*)((char*)Mb + (r * D + c) * 2u) = w; }
                asm volatile("" ::: "memory"); }
    }
};

struct EpiRes {
    static constexpr bool PERM = false, MIDK = false;
    float* X; const float* G; const float* XS;
    __device__ __forceinline__ void operator()(const Acc& acc, const Unit& u, int wr, int wc, int fr, int fq) const {
        const int row0 = u.pm * BM + wr * 64 + fr, col0 = u.pn * BM + wc * 32 + 4 * fq;
        const float* gp = G + (size_t)(u.pm >> 3) * NMOD + col0;
        f32x4 gv[2][2];
#pragma unroll
        for (int bj = 0; bj < 2; ++bj)
#pragma unroll
            for (int n = 0; n < 2; ++n) gv[bj][n] = *(const f32x4*)(gp + bj * HALF + n * 16);
#pragma unroll
        for (int ai = 0; ai < 2; ++ai)
#pragma unroll
            for (int m = 0; m < 4; ++m) { const size_t ro = (size_t)(row0 + ai * HALF + m * 16) * D + col0;
#pragma unroll
                for (int bj = 0; bj < 2; ++bj)
#pragma unroll
                    for (int n = 0; n < 2; ++n) { const size_t o = ro + bj * HALF + n * 16; *(f32x4*)(X + o) = *(const f32x4*)(XS + o) + gv[bj][n] * acc[ai][bj][m][n]; } }
    }
};

struct EpiFfn {
    static constexpr bool PERM = true, MIDK = false;
    bf16_t* ACT;
    __device__ __forceinline__ void operator()(const Acc& acc, const Unit& u, int wr, int wc, int fr, int fq) const {
        const int row0 = u.pm * BM + wr * 64 + fr, col0 = u.pn * HALF + wc * 32 + 8 * fq;
#pragma unroll
        for (int ai = 0; ai < 2; ++ai)
#pragma unroll
            for (int m = 0; m < 4; ++m) { bf16_t* rp = ACT + (size_t)(row0 + ai * HALF + m * 16) * FF + col0;
                const f32x4 g0 = acc[ai][0][m][0], g1 = acc[ai][0][m][1], u0 = acc[ai][1][m][0], u1 = acc[ai][1][m][1];
                u32x4 w; w.x = cvt_pk_bf16(siluf_(g0[0]) * u0[0], siluf_(g0[1]) * u0[1]); w.y = cvt_pk_bf16(siluf_(g0[2]) * u0[2], siluf_(g0[3]) * u0[3]);
                w.z = cvt_pk_bf16(siluf_(g1[0]) * u1[0], siluf_(g1[1]) * u1[1]); w.w = cvt_pk_bf16(siluf_(g1[2]) * u1[2], siluf_(g1[3]) * u1[3]);
                *(u32x4*)rp = w; }
    }
};
}

template <class F>
__device__ __forceinline__ void sample_gemm(LAS unsigned char* lds, const bf16_t* A  , int lda, const bf16_t* Bt, int ldb, int kofs, int K, const F& epi) {
    const int tid = TID(), wid = __builtin_amdgcn_readfirstlane(tid >> 6), lane = tid & 63, fr = lane & 15, fq = lane >> 4;
    LAS f32x4* red = (LAS f32x4*)lds;
    const int kw = K / 8;
    for (int it = blockIdx.x; it < 256; it += gridDim.x) {
        const int rb = it >> 6, cbk = it & 63;
        f32x4 a0 = (f32x4){0.f, 0.f, 0.f, 0.f}, a1 = a0;
        const bf16_t* ap = A + (size_t)(rb * 32 + fr) * lda + kofs + wid * kw + 8 * fq;
        const bf16_t* bp = Bt + (size_t)(cbk * 16 + fr) * ldb + kofs + wid * kw + 8 * fq;
        for (int k = 0; k < kw; k += 128) {
            bf16x8 av0[4], av1[4], bv[4];
#pragma unroll
            for (int q = 0; q < 4; ++q) if (k + 32 * q < kw) { av0[q] = *(const bf16x8*)(ap + k + 32 * q); av1[q] = *(const bf16x8*)(ap + (size_t)16 * lda + k + 32 * q); bv[q] = *(const bf16x8*)(bp + k + 32 * q); }
#pragma unroll
            for (int q = 0; q < 4; ++q) if (k + 32 * q < kw) { a0 = __builtin_amdgcn_mfma_f32_16x16x32_bf16(av0[q], bv[q], a0, 0, 0, 0); a1 = __builtin_amdgcn_mfma_f32_16x16x32_bf16(av1[q], bv[q], a1, 0, 0, 0); }
        }
        __syncthreads();
        red[(wid * 2 + 0) * 64 + lane] = a0; red[(wid * 2 + 1) * 64 + lane] = a1;
        __syncthreads();
        if (tid < 128) {
            const int mt = tid >> 6; f32x4 s = (f32x4){0.f, 0.f, 0.f, 0.f};
#pragma unroll
            for (int w = 0; w < 8; ++w) s += red[(w * 2 + mt) * 64 + lane];
            const int col = cbk * 16 + fr, rowb = rb * 32 + mt * 16 + 4 * fq;
#pragma unroll
            for (int i = 0; i < 4; ++i) epi(rowb + i, col, s[i]);
        }
    }
    __syncthreads();
}

struct SampEpiBranch { bf16_t* Mb; const bf16_t* Z; int sub;
    __device__ __forceinline__ void operator()(int r, int c, float v) const { const size_t row = (size_t)(MP + r); const float gt = bf2f(Z[row * ZC + ZGATE + sub * D + c]); const float mo = sub ? bf2f(Mb[row * D + c]) : 0.f;
        Mb[row * D + c] = (bf16_t)(cvt_pk_bf16(mo + gt * v, 0.f) & 0xffffu); } };
struct SampEpiRes { float* X; const float* Gm; const float* XS;
    __device__ __forceinline__ void operator()(int r, int c, float v) const { X[(size_t)(MP + r) * D + c] = XS[(size_t)r * D + c] + Gm[(size_t)(NBP + r) * NMOD + c] * v; } };

__device__ __forceinline__ void sample_gemm_branch(LAS unsigned char* lds, const bf16_t* A, const bf16_t* Bt, bf16_t* Mb, const bf16_t* Z) {
    const int tid = TID(), wid = __builtin_amdgcn_readfirstlane(tid >> 6), lane = tid & 63, fr = lane & 15, fq = lane >> 4;
    LAS f32x4* red = (LAS f32x4*)lds;
    for (int it = blockIdx.x; it < 256; it += gridDim.x) {
        const int rb = it >> 6, cbk = it & 63;
        f32x4 a0 = (f32x4){0.f, 0.f, 0.f, 0.f}, a1 = a0;
        const bf16_t* ap = A + (size_t)(rb * 32 + fr) * D + wid * 128 + 8 * fq;
        const bf16_t* bp = Bt + (size_t)(cbk * 16 + fr) * D + wid * 128 + 8 * fq;
        bf16x8 av0[4], av1[4], bv[4];
#pragma unroll
        for (int q = 0; q < 4; ++q) { av0[q] = *(const bf16x8*)(ap + 32 * q); av1[q] = *(const bf16x8*)(ap + (size_t)16 * D + 32 * q); bv[q] = *(const bf16x8*)(bp + 32 * q); }
        const int mt = tid >> 6, col = cbk * 16 + fr, rowb = rb * 32 + (mt & 1) * 16 + 4 * fq;
        unsigned short gt[4][3];
        if (tid < 128) {
#pragma unroll
            for (int i = 0; i < 4; ++i)
#pragma unroll
                for (int sb = 0; sb < 3; ++sb) gt[i][sb] = Z[(size_t)(MP + rowb + i) * ZC + ZGATE + sb * D + col]; }
#pragma unroll
        for (int q = 0; q < 4; ++q) { a0 = __builtin_amdgcn_mfma_f32_16x16x32_bf16(av0[q], bv[q], a0, 0, 0, 0); a1 = __builtin_amdgcn_mfma_f32_16x16x32_bf16(av1[q], bv[q], a1, 0, 0, 0); }
        __syncthreads();
        red[(wid * 2 + 0) * 64 + lane] = a0; red[(wid * 2 + 1) * 64 + lane] = a1;
        __syncthreads();
        if (tid < 128) {
            const f32x4 ya = (red[(0 * 2 + mt) * 64 + lane] + red[(1 * 2 + mt) * 64 + lane]) + (red[(2 * 2 + mt) * 64 + lane] + red[(3 * 2 + mt) * 64 + lane]);
            const f32x4 yb = red[(4 * 2 + mt) * 64 + lane] + red[(5 * 2 + mt) * 64 + lane];
            const f32x4 yc = red[(6 * 2 + mt) * 64 + lane] + red[(7 * 2 + mt) * 64 + lane];
#pragma unroll
            for (int i = 0; i < 4; ++i) { const float v = bf2f(gt[i][0]) * ya[i] + bf2f(gt[i][1]) * yb[i] + bf2f(gt[i][2]) * yc[i];
                Mb[(size_t)(MP + rowb + i) * D + col] = (bf16_t)(cvt_pk_bf16(v, 0.f) & 0xffffu); }
        }
    }
    __syncthreads();
}

__device__ __forceinline__ void transpose_item(const float* W, int N, bf16_t* WT, int ldt, int k0, int n0, int drow0, LAS float* scr, int lane) {
    float tv[32];
#pragma unroll
    for (int i = 0; i < 32; ++i) { const int kk = 2 * i + (lane >> 5); tv[i] = __builtin_nontemporal_load(W + (size_t)(k0 + kk) * N + n0 + (lane & 31)); }
#pragma unroll
    for (int i = 0; i < 32; ++i) { const int kk = 2 * i + (lane >> 5); scr[kk * 33 + (lane & 31)] = tv[i]; }
    asm volatile("s_waitcnt lgkmcnt(0)" ::: "memory");
    const int c = lane & 7;
#pragma unroll
    for (int j = 0; j < 4; ++j) { const int n = (lane >> 3) + 8 * j; const LAS float* s = scr + (8 * c) * 33 + n;
        u32x4 o; o.x = cvt_pk_bf16(s[0 * 33], s[1 * 33]); o.y = cvt_pk_bf16(s[2 * 33], s[3 * 33]); o.z = cvt_pk_bf16(s[4 * 33], s[5 * 33]); o.w = cvt_pk_bf16(s[6 * 33], s[7 * 33]);
        *(u32x4*)(WT + (size_t)(drow0 + n) * ldt + k0 + 8 * c) = o; }
    asm volatile("s_waitcnt lgkmcnt(0)" ::: "memory");
}

struct Args { const float* in[24]; float* out; unsigned char* ws; int ph_lo, ph_hi; };

__device__ __forceinline__ void prologue(const Args& a, LAS unsigned char* lds, int part, int slot0, int nslots, int tslots) {
    const int tid = TID(), lane = tid & 63, wave = __builtin_amdgcn_readfirstlane(tid >> 6);
    const int G = gridDim.x, gw = blockIdx.x * 8 + wave, NGW = G * 8;
    unsigned char* ws = a.ws;
    LAS float* scr = (LAS float*)(lds + wave * 16384);
    constexpr int I_ADA = 16 * 192, I_IN = 16 * 184, I_BA = 8 * 32, I_BC = 4 * 32, I_O = 16 * 32, I_FI = 16 * 176, I_FO = 44 * 32;
    constexpr int I_L = I_ADA + I_IN + I_BA + I_BC + I_O + I_FI + I_FO;
    if (part == 0) {
        for (int it = gw; it < DEPTH * I_ADA; it += NGW) { const int l = it / I_ADA, r = it - l * I_ADA; const int kb = r / 192, nb = r % 192;
            transpose_item(INP(6) + (size_t)l * D * NADA, NADA, (bf16_t*)(ws + WS_WADA) + (size_t)l * NADA * D, D, kb * 64, nb * 32, nb * 32, scr, lane); }
    } else
    for (int sl = slot0; sl < slot0 + nslots; ++sl)
    for (int it = sl; it < DEPTH * (I_L - I_ADA); it += tslots) {
        const int l = it / (I_L - I_ADA); int r = it - l * (I_L - I_ADA) + I_ADA;
        if (r < I_ADA) { const int kb = r / 192, nb = r % 192; transpose_item(INP(6) + (size_t)l * D * NADA, NADA, (bf16_t*)(ws + WS_WADA) + (size_t)l * NADA * D, D, kb * 64, nb * 32, nb * 32, scr, lane); continue; } r -= I_ADA;
        if (r < I_IN) { const int kb = r / 184, nb = r % 184; transpose_item(INP(8) + (size_t)l * D * INC, INC, (bf16_t*)(ws + WS_WIN) + (size_t)l * INC * D, D, kb * 64, nb * 32, nb * 32, scr, lane); continue; } r -= I_IN;
        if (r < I_BA) { const int kb = r / 32, nb = r % 32; transpose_item(INP(17) + (size_t)l * 512 * D, D, (bf16_t*)(ws + WS_WBR) + (size_t)l * D * D, D, kb * 64, nb * 32, nb * 32, scr, lane); continue; } r -= I_BA;
        if (r < I_BC) { const int kb = r / 32, nb = r % 32; transpose_item(INP(19) + (size_t)l * 256 * D, D, (bf16_t*)(ws + WS_WBR) + (size_t)l * D * D + 768, D, kb * 64, nb * 32, nb * 32, scr, lane); continue; } r -= I_BC;
        if (r < I_O) { const int kb = r / 32, nb = r % 32; transpose_item(INP(20) + (size_t)l * D * D, D, (bf16_t*)(ws + WS_WOUT) + (size_t)l * D * D, D, kb * 64, nb * 32, nb * 32, scr, lane); continue; } r -= I_O;
        if (r < I_FI) { const int kb = r / 176, nb = r % 176; const int n0 = nb * 32; const int cc = n0 < FF ? n0 : n0 - FF; const int dr = (cc >> 7) * 256 + (n0 < FF ? 0 : 128) + (cc & 127);
            transpose_item(INP(21) + (size_t)l * D * 2 * FF, 2 * FF, (bf16_t*)(ws + WS_WFI) + (size_t)l * 2 * FF * D, D, kb * 64, n0, dr, scr, lane); continue; } r -= I_FI;
        { const int kb = r / 32, nb = r % 32; transpose_item(INP(22) + (size_t)l * FF * D, D, (bf16_t*)(ws + WS_WFO) + (size_t)l * D * FF, FF, kb * 64, nb * 32, nb * 32, scr, lane); }
    }
    if (part == 1)
    for (int it = gw; it < DEPTH * 4 * 16 * 8; it += NGW) {
        const int l = it >> 9, g = (it >> 7) & 3, nblk = (it >> 3) & 15, c8 = it & 7, n = nblk * 64 + lane;
        const float* mp = INP(11) + ((size_t)(l * 4 + g) * 64 + c8 * 8) * 64; const float* sc = INP(12) + l * 256 + g * 64; const float* wb = INP(18) + ((size_t)l * 256 + g * 64) * D + n;
        float acc[8];
#pragma unroll
        for (int j = 0; j < 8; ++j) acc[j] = 0.f;
        for (int d0 = 0; d0 < 64; d0 += 16) { float wv[16];
#pragma unroll
            for (int dd = 0; dd < 16; ++dd) wv[dd] = wb[(size_t)(d0 + dd) * D];
#pragma unroll
            for (int dd = 0; dd < 16; ++dd) { const float w = wv[dd] * sc[d0 + dd];
#pragma unroll
                for (int j = 0; j < 8; ++j) acc[j] += mp[j * 64 + d0 + dd] * w; } }
        u32x4 o; o.x = cvt_pk_bf16(acc[0], acc[1]); o.y = cvt_pk_bf16(acc[2], acc[3]); o.z = cvt_pk_bf16(acc[4], acc[5]); o.w = cvt_pk_bf16(acc[6], acc[7]);
        *(u32x4*)((bf16_t*)(ws + WS_WBR) + (size_t)l * D * D + (size_t)n * D + 512 + g * 64 + c8 * 8) = o;
    }
    if (part == 1) { bf16_t* Wc = (bf16_t*)(ws + WS_CWS); const float* src = INP(15);
      for (int i = blockIdx.x * 512 + tid; i < DEPTH * 4 * 128 * 128 / 4; i += G * 512) { const int e = i * 4, t = (e >> 7) & 127, s0 = e & 127; const f32x4 v = *(const f32x4*)(src + e);
          u32x2 o; o.x = cvt_pk_bf16(s0 <= t ? v[0] : 0.f, s0 + 1 <= t ? v[1] : 0.f); o.y = cvt_pk_bf16(s0 + 2 <= t ? v[2] : 0.f, s0 + 3 <= t ? v[3] : 0.f); *(u32x2*)(Wc + e) = o; } }
    if (part == 0) { bf16_t* C = (bf16_t*)(ws + WS_COND);
      for (int i = blockIdx.x * 512 + tid; i < 256 * D / 4; i += G * 512) { const int row = i >> 8, c4 = (i & 255) * 4; f32x4 v = (f32x4){0.f, 0.f, 0.f, 0.f};
          if (row < NBP) v = *(const f32x4*)(INP(4) + (size_t)row * D + c4); else if (row < NMODROW) v = *(const f32x4*)(INP(5) + (size_t)(row - NBP) * D + c4);
          u32x2 o; o.x = cvt_pk_bf16(siluf_(v[0]), siluf_(v[1])); o.y = cvt_pk_bf16(siluf_(v[2]), siluf_(v[3])); *(u32x2*)(C + (size_t)row * D + c4) = o; } }
    if (part == 0 && blockIdx.x == 0) { float* LB = (float*)(ws + WS_LB); const float* lg = INP(9); const int k = tid;
        const float x0 = lg[k], x1 = lg[512 + k], x2 = lg[1024 + k], x3 = lg[1536 + k]; const float mx = fmaxf(fmaxf(x0, x1), fmaxf(x2, x3));
        const float e0 = expf(x0 - mx), e1 = expf(x1 - mx), e2 = expf(x2 - mx), e3 = expf(x3 - mx), inv = 1.0f / (e0 + e1 + e2 + e3);
        LB[k] = 0.f; LB[512 + k] = fmaxf(e1 * inv, 0.f); LB[1024 + k] = fmaxf((e1 + e2) * inv, 0.f); LB[1536 + k] = fmaxf((e1 + e2 + e3) * inv, 0.f); }
}

__device__ __forceinline__ void norm_phase(const Args& a, int l, int which, bool first) {
    const int tid_ = TID(), lane = tid_ & 63, wave = tid_ >> 6, gw = blockIdx.x * 8 + wave, NGW = gridDim.x * 8;
    float* X = a.out; bf16_t* H = (bf16_t*)(a.ws + WS_H); const float* MODp = (const float*)(a.ws + WS_MOD) + l * NADA + which * 3 * D;
    const float* xp = INP(0); const float* xs = INP(1);
    for (int rb = gw; rb < MV; rb += 4 * NGW) {
        f32x4 v[4][4]; float s[4];
#pragma unroll
        for (int q = 0; q < 4; ++q) { const int r = rb + q * NGW; s[q] = 0.f;
            if (r < MV) { const float* xr = first ? (r < MP ? xp + (size_t)r * D : xs + (size_t)(r - MP) * D) : X + (size_t)r * D;
#pragma unroll
                for (int j = 0; j < 4; ++j) v[q][j] = *(const f32x4*)(xr + 4 * lane + 256 * j); }
            else {
#pragma unroll
                for (int j = 0; j < 4; ++j) v[q][j] = (f32x4){0.f, 0.f, 0.f, 0.f}; } }
#pragma unroll
        for (int q = 0; q < 4; ++q)
#pragma unroll
            for (int j = 0; j < 4; ++j) s[q] += (v[q][j][0] * v[q][j][0] + v[q][j][1] * v[q][j][1]) + (v[q][j][2] * v[q][j][2] + v[q][j][3] * v[q][j][3]);
#pragma unroll
        for (int o = 1; o < 64; o <<= 1) {
#pragma unroll
            for (int q = 0; q < 4; ++q) s[q] += __shfl_xor(s[q], o); }
#pragma unroll
        for (int q = 0; q < 4; ++q) { const int r = rb + q * NGW; if (r < MV) {
            const float rstd = rsqrtf(s[q] * (1.0f / D) + 1e-6f);
            const float* mr = MODp + (size_t)mod_row(r) * NMOD;
#pragma unroll
            for (int j = 0; j < 4; ++j) { const int c = 4 * lane + 256 * j; const f32x4 sh = *(const f32x4*)(mr + c), sc = *(const f32x4*)(mr + D + c); const f32x4 o = v[q][j] * rstd * (sc + 1.0f) + sh;
                u32x2 w; w.x = cvt_pk_bf16(o[0], o[1]); w.y = cvt_pk_bf16(o[2], o[3]); *(u32x2*)(H + (size_t)r * D + c) = w; } } }
    }
}
__device__ __forceinline__ void final_phase(const Args& a) {
    const int tid_ = TID(), lane = tid_ & 63, wave = tid_ >> 6, gw = blockIdx.x * 8 + wave, NGW = gridDim.x * 8;
    float* X = a.out; const float* fg = INP(23);
    f32x4 fgv[4];
#pragma unroll
    for (int j = 0; j < 4; ++j) fgv[j] = *(const f32x4*)(fg + 4 * lane + 256 * j);
    for (int rb = gw; rb < MV; rb += 4 * NGW) {
        f32x4 v[4][4]; float s[4];
#pragma unroll
        for (int q = 0; q < 4; ++q) { const int r = rb + q * NGW; s[q] = 0.f;
#pragma unroll
            for (int j = 0; j < 4; ++j) v[q][j] = (r < MV) ? *(const f32x4*)(X + (size_t)r * D + 4 * lane + 256 * j) : (f32x4){0.f, 0.f, 0.f, 0.f}; }
#pragma unroll
        for (int q = 0; q < 4; ++q)
#pragma unroll
            for (int j = 0; j < 4; ++j) s[q] += (v[q][j][0] * v[q][j][0] + v[q][j][1] * v[q][j][1]) + (v[q][j][2] * v[q][j][2] + v[q][j][3] * v[q][j][3]);
#pragma unroll
        for (int o = 1; o < 64; o <<= 1) {
#pragma unroll
            for (int q = 0; q < 4; ++q) s[q] += __shfl_xor(s[q], o); }
#pragma unroll
        for (int q = 0; q < 4; ++q) { const int r = rb + q * NGW; if (r < MV) { const float rstd = rsqrtf(s[q] * (1.0f / D) + 1e-6f);
#pragma unroll
            for (int j = 0; j < 4; ++j) *(f32x4*)(X + (size_t)r * D + 4 * lane + 256 * j) = v[q][j] * rstd * fgv[j]; } }
    }
}

typedef __bf16 bf16x2_t __attribute__((ext_vector_type(2)));
__device__ __forceinline__ unsigned cvtpk(float lo, float hi) { f32x2 v = {lo, hi}; bf16x2_t b = __builtin_convertvector(v, bf16x2_t); return __builtin_bit_cast(unsigned, b); }
constexpr int HQ_P = 136, HK_P = 24, HO_P = 132;
template <bool PASS3>
__device__ __forceinline__ void hgrn_unit(const Args& a, LAS unsigned char* lds, int l, int b, int h, int j) {
    const int tid = TID(), lane = tid & 63, w = __builtin_amdgcn_readfirstlane(tid >> 6), c16 = lane & 15, g = lane >> 4;
    LAS bf16_t* QT = (LAS bf16_t*)lds;
    LAS bf16_t* KT = QT + 16 * HQ_P;
    LAS bf16_t* KH = KT + 16 * HQ_P;
    LAS bf16_t* VT = KH + 128 * HK_P;
    LAS float* DD = (LAS float*)(VT + 128 * HK_P);
    LAS float* TOT = DD + 128;
    LAS float* OB = TOT + 512;
    const float* QFK = (const float*)(a.ws + WS_QFK); const bf16_t* Z = (const bf16_t*)(a.ws + WS_Z);
    float* U = (float*)(a.ws + WS_U); float* DU = (float*)(a.ws + WS_DU);
    const int bh = b * 4 + h, t0 = b * SEQ + j * SPAN;
    const int pk = tid & 127, tq = tid >> 7;
    f32x4 S[8];
#pragma unroll
    for (int kt = 0; kt < 8; ++kt) S[kt] = (f32x4){0.f, 0.f, 0.f, 0.f};
    if (PASS3) {
        for (int jj = 0; jj < j; ++jj) { const float* up = U + (size_t)(bh * NSPAN + jj) * 16384 + (size_t)w * 2048 + lane * 4; const float* dp = DU + (size_t)(bh * NSPAN + jj) * 128;
#pragma unroll
            for (int kt = 0; kt < 8; ++kt) { const f32x4 dd = *(const f32x4*)(dp + 16 * kt + 4 * g);
                S[kt] = dd * S[kt] + *(const f32x4*)(up + kt * 256); } }
    }
    float bsum = 0.f;
    float rfA[2][4], rqA[2][4], rkA[2][4]; unsigned rvA[2][4];
#pragma unroll
    for (int pp = 0; pp < 2; ++pp)
#pragma unroll
        for (int i = 0; i < 4; ++i) { const size_t row = (size_t)(t0 + pp * 16 + 4 * tq + i); const unsigned char* bp = (const unsigned char*)QFK + row * QFKB; if (PASS3) rqA[pp][i] = bf2f(*(const bf16_t*)(bp + QFK_Q + (h * 128 + pk) * 2)); rkA[pp][i] = *(const float*)(bp + (h * 128 + pk) * 4); rfA[pp][i] = fmaxf(1.0f - rkA[pp][i], 1e-30f); rvA[pp][i] = Z[row * ZC + ZV + h * 128 + pk]; }
    const int tt_n = tid >> 5, c4_n = (tid & 31) * 4;
    f32x4 gn = (f32x4){0.f, 0.f, 0.f, 0.f};
    if (PASS3) gn = *(const f32x4*)(INP(10) + (size_t)l * 512 + h * 128 + c4_n);
    for (int blk2 = 0; blk2 < SPAN / 32; ++blk2)
#pragma unroll
    for (int par = 0; par < 2; ++par) {
        const int blk = 2 * blk2 + par;
        float (&rf)[4] = rfA[par]; float (&rq)[4] = rqA[par]; float (&rk)[4] = rkA[par]; unsigned (&rv)[4] = rvA[par];
        u32x2 gg = (u32x2){0u, 0u};
        if (PASS3) gg = *(const u32x2*)(Z + (size_t)(t0 + blk * 16 + tt_n) * ZC + ZG + h * 128 + c4_n);
        float p[4]; { float acc = 0.f;
#pragma unroll
            for (int i = 0; i < 4; ++i) { acc += __logf(rf[i]); p[i] = acc; } }
        TOT[tq * 128 + pk] = p[3];
        LDS_BAR();
        {
            const float t0_ = TOT[pk], t1_ = TOT[128 + pk], t2_ = TOT[256 + pk], t3_ = TOT[384 + pk];
            const float off = tq == 0 ? 0.f : tq == 1 ? t0_ : tq == 2 ? t0_ + t1_ : (t0_ + t1_) + t2_;
            const float b15 = (t0_ + t1_) + (t2_ + t3_);
            float kh[4];
#pragma unroll
            for (int i = 0; i < 4; ++i) { const float bb = off + p[i]; const int t = 4 * tq + i;
                if (PASS3) { const float e = __expf(bb); QT[t * HQ_P + pk] = (bf16_t)(cvtpk(rq[i] * e, 0.f) & 0xffffu); KT[t * HQ_P + pk] = (bf16_t)(cvtpk(rk[i] * __expf(-bb), 0.f) & 0xffffu); }
                kh[i] = rk[i] * __expf(b15 - bb); }
            *(LAS u32x2*)(KH + pk * HK_P + 4 * tq) = (u32x2){cvtpk(kh[0], kh[1]), cvtpk(kh[2], kh[3])};
            *(LAS u32x2*)(VT + pk * HK_P + 4 * tq) = (u32x2){rv[0] | (rv[1] << 16), rv[2] | (rv[3] << 16)};
            if (tq == 0) { DD[pk] = __expf(b15); bsum += b15; }
        }
        if (blk + 2 < SPAN / 16) {
#pragma unroll
            for (int i = 0; i < 4; ++i) { const size_t row = (size_t)(t0 + (blk + 2) * 16 + 4 * tq + i); const unsigned char* bp = (const unsigned char*)QFK + row * QFKB; if (PASS3) rq[i] = bf2f(*(const bf16_t*)(bp + QFK_Q + (h * 128 + pk) * 2)); rk[i] = *(const float*)(bp + (h * 128 + pk) * 4); rf[i] = fmaxf(1.0f - rk[i], 1e-30f); rv[i] = Z[row * ZC + ZV + h * 128 + pk]; }
        }
        LDS_BAR();
        {
            const bf16x8 zero8 = (bf16x8){0, 0, 0, 0, 0, 0, 0, 0};
            if (PASS3) {
                f32x4 oT = (f32x4){0.f, 0.f, 0.f, 0.f}, AT = (f32x4){0.f, 0.f, 0.f, 0.f};
#pragma unroll
                for (int s2 = 0; s2 < 4; ++s2) {
                    const u32x4 aw = (u32x4){cvtpk(S[2 * s2][0], S[2 * s2][1]), cvtpk(S[2 * s2][2], S[2 * s2][3]), cvtpk(S[2 * s2 + 1][0], S[2 * s2 + 1][1]), cvtpk(S[2 * s2 + 1][2], S[2 * s2 + 1][3])};
                    const u32x2 q0 = *(const LAS u32x2*)(QT + c16 * HQ_P + 32 * s2 + 4 * g), q1 = *(const LAS u32x2*)(QT + c16 * HQ_P + 32 * s2 + 16 + 4 * g);
                    const u32x4 bw = (u32x4){q0.x, q0.y, q1.x, q1.y};
                    oT = __builtin_amdgcn_mfma_f32_16x16x32_bf16(__builtin_bit_cast(bf16x8, aw), __builtin_bit_cast(bf16x8, bw), oT, 0, 0, 0);
                    const bf16x8 ka = *(const LAS bf16x8*)(KT + c16 * HQ_P + 32 * s2 + 8 * g), qb = *(const LAS bf16x8*)(QT + c16 * HQ_P + 32 * s2 + 8 * g);
                    AT = __builtin_amdgcn_mfma_f32_16x16x32_bf16(ka, qb, AT, 0, 0, 0);
                }
#pragma unroll
                for (int i = 0; i < 4; ++i) AT[i] = (4 * g + i <= c16) ? AT[i] : 0.f;
                const u32x4 atw = (u32x4){cvtpk(AT[0], AT[1]), cvtpk(AT[2], AT[3]), 0u, 0u};
                const u32x2 vv = *(const LAS u32x2*)(VT + (16 * w + c16) * HK_P + 4 * g);
                const u32x4 vw = (u32x4){vv.x, vv.y, 0u, 0u};
                oT = __builtin_amdgcn_mfma_f32_16x16x32_bf16(__builtin_bit_cast(bf16x8, vw), __builtin_bit_cast(bf16x8, atw), oT, 0, 0, 0);
                *(LAS f32x4*)(OB + c16 * HO_P + 16 * w + 4 * g) = oT;
            }
            bf16x8 vb = zero8; if (g < 2) vb = *(const LAS bf16x8*)(VT + (16 * w + c16) * HK_P + 8 * g);
#pragma unroll
            for (int kt = 0; kt < 8; ++kt) {
                bf16x8 ka = zero8; if (g < 2) ka = *(const LAS bf16x8*)(KH + (16 * kt + c16) * HK_P + 8 * g);
                const f32x4 dd = *(const LAS f32x4*)(DD + 16 * kt + 4 * g);
                S[kt] = __builtin_amdgcn_mfma_f32_16x16x32_bf16(ka, vb, S[kt] * dd, 0, 0, 0);
            }
        }
        LDS_BAR();
        if (PASS3) {
            const int tt = tid >> 5, c4 = (tid & 31) * 4;
            const f32x4 o = *(const LAS f32x4*)(OB + tt * HO_P + c4);
            float ss = (o[0] * o[0] + o[1] * o[1]) + (o[2] * o[2] + o[3] * o[3]);
#pragma unroll
            for (int m = 1; m < 32; m <<= 1) ss += __shfl_xor(ss, m);
            const float rstd = rsqrtf(ss * (1.0f / 128.0f) + 1e-6f);
            const size_t row = (size_t)(t0 + blk * 16 + tt);
            u32x2 wv; wv.x = cvtpk(o[0] * rstd * gn[0] * bflo(gg.x), o[1] * rstd * gn[1] * bfhi(gg.x)); wv.y = cvtpk(o[2] * rstd * gn[2] * bflo(gg.y), o[3] * rstd * gn[3] * bfhi(gg.y));
            *(u32x2*)((bf16_t*)(a.ws + WS_MIX) + row * D + h * 128 + c4) = wv;
        }
    }
    if (!PASS3) {
        float* up = U + (size_t)(bh * NSPAN + j) * 16384 + (size_t)w * 2048 + lane * 4;
#pragma unroll
        for (int kt = 0; kt < 8; ++kt) *(f32x4*)(up + kt * 256) = S[kt];
        if (tq == 0) DU[(size_t)(bh * NSPAN + j) * 128 + pk] = __expf(bsum);
    } else if (j == NSPAN - 1) {
        float* hp = a.out + O_HP + ((size_t)(l * NBP + b) * 4 + h) * 16384 + 16 * w + c16;
#pragma unroll
        for (int kt = 0; kt < 8; ++kt)
#pragma unroll
            for (int i = 0; i < 4; ++i) hp[(size_t)(16 * kt + 4 * g + i) * 128] = S[kt][i];
    }
    __syncthreads();
}

__device__ __forceinline__ void hgrn_sample_unit(const Args& a, LAS unsigned char* lds, int l, int b, int h) {
    const int tid = TID(), v = tid & 127, kq = tid >> 7;
    LAS float* red = (LAS float*)lds;
    const size_t row = (size_t)(MP + b);
    const unsigned char* qb_ = (const unsigned char*)(a.ws + WS_QFK) + row * QFKB; const float* qF = (const float*)qb_ + h * 128; const bf16_t* qQ = (const bf16_t*)(qb_ + QFK_Q) + h * 128; const bf16_t* Z = (const bf16_t*)(a.ws + WS_Z) + row * ZC;
    const float vv = bf2f(Z[ZV + h * 128 + v]);
    const float* sp = INP(2) + (((size_t)l * MS + b) * 4 + h) * 16384 + (size_t)(kq * 32) * 128 + v;
    float* so = a.out + O_HS + (((size_t)l * MS + b) * 4 + h) * 16384 + (size_t)(kq * 32) * 128 + v;
    float o = 0.f;
    float sv[32];
#pragma unroll
    for (int i = 0; i < 32; ++i) sv[i] = __builtin_nontemporal_load(sp + (size_t)i * 128);
#pragma unroll
    for (int i = 0; i < 32; ++i) { const int k = kq * 32 + i; const float kk_ = qF[k]; const float s = (1.0f - kk_) * sv[i] + kk_ * vv; __builtin_nontemporal_store(s, so + (size_t)i * 128); o += bf2f(qQ[k]) * s; }
    __syncthreads();
    red[kq * 128 + v] = o;
    __syncthreads();
    if (tid < 128) {
        const float ot = (red[v] + red[128 + v]) + (red[256 + v] + red[384 + v]);
        float ss = wave_sum(ot * ot);
        red[512 + (tid >> 6)] = ss;
    }
    __syncthreads();
    if (tid < 128) {
        const float ot = (red[v] + red[128 + v]) + (red[256 + v] + red[384 + v]);
        const float rstd = rsqrtf((red[512] + red[513]) * (1.0f / 128.0f) + 1e-6f);
        const float val = ot * rstd * INP(10)[(size_t)l * 512 + h * 128 + v] * bf2f(Z[ZG + h * 128 + v]);
        ((bf16_t*)(a.ws + WS_MIX))[row * D + h * 128 + v] = (bf16_t)(cvt_pk_bf16(val, 0.f) & 0xffffu);
    }
    __syncthreads();
}

__device__ __forceinline__ void pool_phase(const Args& a, int l) {
    const int gt = blockIdx.x * 512 + TID(), NT = gridDim.x * 512;
    const bf16_t* Z = (const bf16_t*)(a.ws + WS_Z); bf16_t* MIX = (bf16_t*)(a.ws + WS_MIX);
    for (int it = gt; it < MP * 32; it += NT) {
        const int r = it >> 5, c8 = (it & 31) * 8, t = r & (SEQ - 1), wnd = 2 << (c8 >> 6);
        const int n = (t + 1 < wnd) ? t + 1 : wnd;
        float s[8];
#pragma unroll
        for (int q = 0; q < 8; ++q) s[q] = 0.f;
        u32x4 cur = *(const u32x4*)(Z + (size_t)r * ZC + ZP + c8);
        u32x4 pv[15];
#pragma unroll
        for (int i = 1; i < 16; ++i) pv[i - 1] = (i < n) ? *(const u32x4*)(Z + (size_t)(r - i) * ZC + ZP + c8) : (u32x4){0u, 0u, 0u, 0u};
#pragma unroll
        for (int i = 0; i < 15; ++i) { const u32x4 p = pv[i];
            s[0] += bflo(p.x); s[1] += bfhi(p.x); s[2] += bflo(p.y); s[3] += bfhi(p.y); s[4] += bflo(p.z); s[5] += bfhi(p.z); s[6] += bflo(p.w); s[7] += bfhi(p.w); }
        const float x[8] = {bflo(cur.x), bfhi(cur.x), bflo(cur.y), bfhi(cur.y), bflo(cur.z), bfhi(cur.z), bflo(cur.w), bfhi(cur.w)};
        const float inv = 1.0f / (float)n; float z[8];
#pragma unroll
        for (int q = 0; q < 8; ++q) z[q] = (s[q] + x[q]) * inv - x[q];
        u32x4 o; o.x = cvt_pk_bf16(z[0], z[1]); o.y = cvt_pk_bf16(z[2], z[3]); o.z = cvt_pk_bf16(z[4], z[5]); o.w = cvt_pk_bf16(z[6], z[7]);
        *(u32x4*)(MIX + (size_t)r * D + 512 + c8) = o;
    }
    for (int it = gt; it < MS * 256; it += NT) {
        const int b = it >> 8, c = it & 255, wnd = 2 << (c >> 6);
        const float* st = INP(3) + ((size_t)l * MS + b) * 15 * 256 + c;
        const float x = bf2f(Z[(size_t)(MP + b) * ZC + ZP + c]);
        float stv[15];
#pragma unroll
        for (int i = 0; i < 15; ++i) stv[i] = st[(size_t)i * 256];
        float s = x;
#pragma unroll
        for (int i = 1; i < 16; ++i) s += (i < wnd) ? stv[15 - i] : 0.f;
        const float z = s / (float)wnd - x;
        MIX[(size_t)(MP + b) * D + 512 + c] = (bf16_t)(cvt_pk_bf16(z, 0.f) & 0xffffu);
        float* ps = a.out + O_PS + ((size_t)l * MS + b) * 15 * 256 + c;
#pragma unroll
        for (int i = 0; i < 14; ++i) ps[(size_t)i * 256] = stv[i + 1];
        ps[(size_t)14 * 256] = x;
    }
    for (int it = gt; it < NBP * 15 * 256; it += NT) {
        const int b = it / (15 * 256), rem = it - b * 15 * 256, i = rem >> 8, c = rem & 255;
        a.out[O_PP + ((size_t)l * NBP + b) * 15 * 256 + rem] = bf2f(Z[(size_t)(b * SEQ + SEQ - 15 + i) * ZC + ZP + c]);
    }
}

constexpr int GV_P = 136;
__device__ __forceinline__ void gating_unit(const Args& a, LAS unsigned char* lds, int l, int unit) {
    const int tid = TID(), lane = tid & 63, w = __builtin_amdgcn_readfirstlane(tid >> 6), c16 = lane & 15, g4 = lane >> 4;
    const int g = unit & 3, ch = (unit >> 2) & 15, b = unit >> 6, r0 = b * SEQ + ch * 128;
    LAS bf16_t* vnT = (LAS bf16_t*)lds;
    const bf16_t* Z = (const bf16_t*)(a.ws + WS_Z); bf16_t* MIX = (bf16_t*)(a.ws + WS_MIX);
    const float* lg = INP(13) + l * 256, * lbb = INP(14) + l * 256;
    __syncthreads();
    {
        const int c = 4 * lane; const bool mine = (lane >> 4) == g;
        const f32x4 gg = *(const f32x4*)(lg + c), bb = *(const f32x4*)(lbb + c);
        u32x2 pall[16];
#pragma unroll
        for (int i = 0; i < 16; ++i) pall[i] = *(const u32x2*)(Z + (size_t)(r0 + 16 * w + i) * ZC + ZVC + c);
#pragma unroll
        for (int q = 0; q < 4; ++q) {
            u32x2 p[4];
#pragma unroll
            for (int i = 0; i < 4; ++i) p[i] = pall[4 * q + i];
            float x[4][4], sm[4];
#pragma unroll
            for (int i = 0; i < 4; ++i) { x[i][0] = bflo(p[i].x); x[i][1] = bfhi(p[i].x); x[i][2] = bflo(p[i].y); x[i][3] = bfhi(p[i].y); sm[i] = (x[i][0] + x[i][1]) + (x[i][2] + x[i][3]); }
#pragma unroll
            for (int o = 1; o < 64; o <<= 1) {
#pragma unroll
                for (int i = 0; i < 4; ++i) sm[i] += __shfl_xor(sm[i], o); }
            float sq[4];
#pragma unroll
            for (int i = 0; i < 4; ++i) { const float mu = sm[i] * (1.0f / 256.0f);
#pragma unroll
                for (int e = 0; e < 4; ++e) x[i][e] -= mu;
                sq[i] = (x[i][0] * x[i][0] + x[i][1] * x[i][1]) + (x[i][2] * x[i][2] + x[i][3] * x[i][3]); }
#pragma unroll
            for (int o = 1; o < 64; o <<= 1) {
#pragma unroll
                for (int i = 0; i < 4; ++i) sq[i] += __shfl_xor(sq[i], o); }
            if (mine) {
#pragma unroll
                for (int i = 0; i < 4; ++i) { const float rstd = rsqrtf(sq[i] * (1.0f / 256.0f) + 1e-6f); const int sidx = 16 * w + 4 * q + i;
#pragma unroll
                    for (int e = 0; e < 4; ++e) vnT[((c & 63) + e) * GV_P + sidx] = (bf16_t)(cvt_pk_bf16(x[i][e] * rstd * gg[e] + bb[e], 0.f) & 0xffffu); }
            }
        }
    }
    __syncthreads();
    {
        const bf16_t* Wb = (const bf16_t*)(a.ws + WS_CWS) + (size_t)(l * 4 + g) * 16384 + (size_t)(16 * w + c16) * 128 + 8 * g4;
        const int nks = (w >> 1) + 1;
        bf16x8 af[4];
#pragma unroll
        for (int ks = 0; ks < 4; ++ks) af[ks] = (ks < nks) ? *(const bf16x8*)(Wb + 32 * ks) : (bf16x8){0, 0, 0, 0, 0, 0, 0, 0};
        const float* bs = INP(16) + (size_t)(l * 4 + g) * 128 + 16 * w + 4 * g4;
        const f32x4 bsv = *(const f32x4*)bs;
        unsigned short uu_[4][4];
#pragma unroll
        for (int ct = 0; ct < 4; ++ct)
#pragma unroll
            for (int i = 0; i < 4; ++i) uu_[ct][i] = Z[(size_t)(r0 + 16 * w + 4 * g4 + i) * ZC + ZU + g * 64 + 16 * ct + c16];
#pragma unroll
        for (int ct = 0; ct < 4; ++ct) {
            f32x4 acc = (f32x4){0.f, 0.f, 0.f, 0.f};
#pragma unroll
            for (int ks = 0; ks < 4; ++ks) if (ks < nks) { const bf16x8 bf = *(const LAS bf16x8*)(vnT + (16 * ct + c16) * GV_P + 32 * ks + 8 * g4); acc = __builtin_amdgcn_mfma_f32_16x16x32_bf16(af[ks], bf, acc, 0, 0, 0); }
#pragma unroll
            for (int i = 0; i < 4; ++i) { const size_t row = (size_t)(r0 + 16 * w + 4 * g4 + i); const int cc = g * 64 + 16 * ct + c16;
                const float uu = bf2f(uu_[ct][i]);
                MIX[row * D + 768 + cc] = (bf16_t)(cvt_pk_bf16(uu * (acc[i] + bsv[i]), 0.f) & 0xffffu); }
        }
    }
}
__device__ __forceinline__ void gating_sample(const Args& a, int l) {
    const int tid_ = TID(), lane = tid_ & 63, gw = blockIdx.x * 8 + (tid_ >> 6), NGW = gridDim.x * 8;
    const bf16_t* Z = (const bf16_t*)(a.ws + WS_Z); bf16_t* MIX = (bf16_t*)(a.ws + WS_MIX);
    for (int b = gw; b < MS; b += NGW) {
        const size_t row = (size_t)(MP + b);
        const u32x2 p = *(const u32x2*)(Z + row * ZC + ZVC + 4 * lane);
        const float x0 = bflo(p.x), x1 = bfhi(p.x), x2 = bflo(p.y), x3 = bfhi(p.y);
        const float mu = wave_sum((x0 + x1) + (x2 + x3)) * (1.0f / 256.0f);
        const float d0 = x0 - mu, d1 = x1 - mu, d2 = x2 - mu, d3 = x3 - mu;
        const float rstd = rsqrtf(wave_sum((d0 * d0 + d1 * d1) + (d2 * d2 + d3 * d3)) * (1.0f / 256.0f) + 1e-6f);
        const int c = 4 * lane, g = lane >> 4;
        const f32x4 gg = *(const f32x4*)(INP(13) + l * 256 + c), bb = *(const f32x4*)(INP(14) + l * 256 + c);
        const f32x4 vn = (f32x4){d0 * rstd * gg[0] + bb[0], d1 * rstd * gg[1] + bb[1], d2 * rstd * gg[2] + bb[2], d3 * rstd * gg[3] + bb[3]};
        *(f32x4*)(a.out + O_CV + ((size_t)l * MS + b) * 256 + c) = vn;
        const float w00 = INP(15)[(size_t)(l * 4 + g) * 16384], b0 = INP(16)[(size_t)(l * 4 + g) * 128];
        const u32x2 up = *(const u32x2*)(Z + row * ZC + ZU + c);
        u32x2 o; o.x = cvt_pk_bf16(bflo(up.x) * (w00 * vn[0] + b0), bfhi(up.x) * (w00 * vn[1] + b0)); o.y = cvt_pk_bf16(bflo(up.y) * (w00 * vn[2] + b0), bfhi(up.y) * (w00 * vn[3] + b0));
        *(u32x2*)(MIX + row * D + 768 + c) = o;
    }
}

#define XB_TMO      128
#define XB_XCNT(j)  (256  + 64 * (j))
#define XB_XSUB(j)  (1280 + 64 * (j))
#define XB_XGEN(j)  (2304 + 64 * (j))
#define XB_TOP      3328
#define XB_TOPGEN   3392
#define XCD_BAR_WORDS 3456
#define XB_SPIN_CAP (1u << 18)

__device__ __forceinline__ unsigned xb_ld(unsigned* p)              { return __hip_atomic_load(p, __ATOMIC_RELAXED, __HIP_MEMORY_SCOPE_AGENT); }
__device__ __forceinline__ unsigned xb_add(unsigned* p, unsigned v) { return __hip_atomic_fetch_add(p, v, __ATOMIC_RELAXED, __HIP_MEMORY_SCOPE_AGENT); }
__device__ __forceinline__ unsigned xb_xcc_id() { return (unsigned)__builtin_amdgcn_s_getreg((3 << 11) | 20) & 0xFu; }
#define XB_SPIN(cond, bar) do { unsigned _sp = 0; while (cond) { __builtin_amdgcn_s_sleep(1); \
    if ((++_sp & 255u) == 0u) { if (xb_ld(&(bar)[XB_TMO])) break; if (_sp > XB_SPIN_CAP) { atomicAdd(&(bar)[XB_TMO], 1u); break; } } } } while (0)

struct XcdBarrier {
    unsigned* bar; unsigned x;
    volatile LAS unsigned* st;
};

__device__ __forceinline__ XcdBarrier xcd_barrier_post(unsigned* bar, volatile LAS unsigned* st) {
    XcdBarrier b; b.bar = bar; b.x = xb_xcc_id(); b.st = st;
    if (threadIdx.x == 0) (void)xb_add(&bar[XB_XCNT(b.x)], 1u);
    return b;
}
__device__ __forceinline__ void xcd_barrier_complete(unsigned* bar, unsigned x, unsigned& nloc, unsigned& nx) {
    const unsigned G = gridDim.x * gridDim.y * gridDim.z;
    unsigned sum, cnt, mine, sp = 0u;
    for (;;) {
        sum = 0u; cnt = 0u; mine = 0u;
#pragma unroll
        for (unsigned j = 0; j < 16; ++j) { const unsigned c = xb_ld(&bar[XB_XCNT(j)]); sum += c; cnt += (c > 0u) ? 1u : 0u; mine = (j == x) ? c : mine; }
        if (sum == G) break;
        __builtin_amdgcn_s_sleep(1);
        if ((++sp & 255u) == 0u) { if (xb_ld(&bar[XB_TMO])) break; if (sp > XB_SPIN_CAP) { atomicAdd(&bar[XB_TMO], 1u); break; } }
    }
    nloc = mine > 0u ? mine : 1u; nx = cnt > 0u ? cnt : 1u;
}

__device__ __forceinline__ void xcd_barrier(const XcdBarrier& b) {
    asm volatile("s_waitcnt vmcnt(0)" ::: "memory");
    __syncthreads();
    if (threadIdx.x == 0) {
        unsigned* bar = b.bar;
        __builtin_amdgcn_s_waitcnt(0);
        unsigned nloc = b.st[0], nx = b.st[1];
        if (nloc == 0u) { xcd_barrier_complete(bar, b.x, nloc, nx); b.st[0] = nloc; b.st[1] = nx; }
        const unsigned old = xb_add(&bar[XB_XSUB(b.x)], 1u);
        const unsigned gen = old / nloc;
        if (old + 1u == (gen + 1u) * nloc) {
            __builtin_amdgcn_fence(__ATOMIC_RELEASE, "agent");
            asm volatile("s_waitcnt vmcnt(0)" ::: "memory");
            const unsigned og = xb_add(&bar[XB_TOP], 1u);
            const unsigned tg = og / nx;
            if (og + 1u == (tg + 1u) * nx) xb_add(&bar[XB_TOPGEN], 1u);
            else XB_SPIN(xb_ld(&bar[XB_TOPGEN]) == tg, bar);
            __builtin_amdgcn_fence(__ATOMIC_ACQUIRE, "agent");
            xb_add(&bar[XB_XGEN(b.x)], 1u);
            asm volatile("s_waitcnt vmcnt(0)" ::: "memory");
        } else {
            XB_SPIN(xb_ld(&bar[XB_XGEN(b.x)]) == gen, bar);
            __builtin_amdgcn_fence(__ATOMIC_ACQUIRE, "agent");
            asm volatile("s_waitcnt vmcnt(0)" ::: "memory");
        }
    }
    __syncthreads();
}

constexpr int NSUB = 10;
constexpr int N_PHASES = 2 + NSUB * DEPTH + 1;
#ifndef ENMASK
#define ENMASK 0xffff
#endif
#define EN(k) (((ENMASK) >> (k)) & 1)
__global__ void __launch_bounds__(512, 2) fwd_kernel(Args a) {
    extern __shared__ __attribute__((aligned(16))) unsigned char lds_raw[];
    LAS unsigned char* lds = (LAS unsigned char*)lds_raw;
    cg::grid_group grid = cg::this_grid();
    if (threadIdx.x == 0) { LAS unsigned long long* tb = (LAS unsigned long long*)(lds + PTR_TBL_OFF);
#define PT_(k) tb[k] = (unsigned long long)a.in[k];
        PT_(0) PT_(1) PT_(2) PT_(3) PT_(4) PT_(5) PT_(6) PT_(7) PT_(8) PT_(9) PT_(10) PT_(11) PT_(12) PT_(13) PT_(14) PT_(15) PT_(16) PT_(17) PT_(18) PT_(19) PT_(20) PT_(21) PT_(22) PT_(23)
#undef PT_
    }
    volatile LAS unsigned* bst = (volatile LAS unsigned*)(lds + 131072 + 512);
    if (threadIdx.x < 2) bst[threadIdx.x] = 0u;
    __syncthreads();
    XcdBarrier xbar = xcd_barrier_post((unsigned*)(a.ws + WS_CTL), bst);
#if defined(REPMASK)
    int rep_ = 0;
#endif
    for (int ph = a.ph_lo; ph < a.ph_hi; ++ph) {
        unsigned char* ws = a.ws; int G = gridDim.x, bx = blockIdx.x;
        asm volatile("" : "+s"(ws), "+s"(G), "+s"(bx));
#if defined(REPMASK)
        const int s__ = (ph - 2) % NSUB; const int ty_ = ph == 0 ? 0 : ph == 1 ? 1 : ph == N_PHASES - 1 ? 2 : (s__ == 0 || s__ == 7) ? 3 : (s__ == 1 || s__ == 4) ? 4 : s__ == 2 ? 5 : s__ == 3 ? 6 : s__ == 5 ? 7 : s__ == 8 ? 9 : 8;
#endif
        if (ph == 0) { if (EN(0)) prologue(a, lds, 0, 0, 0, 0); }
        else if (ph == 1 && EN(1)) {
            const int nG = G < 96 ? G : 96, nF = G - nG; const bool gm = bx >= nF; const int wv_ = __builtin_amdgcn_readfirstlane(TID() >> 6);
            if (gm) {
                pg8::Gemm g{(const bf16_t*)(ws + WS_COND), (const bf16_t*)(ws + WS_WADA), D, D}; pg8::Order<1> S; S.init(1, NMOD / 256, nG, bx - nF, 0, D / 64);
                pg8::EpiAda E{(float*)(ws + WS_MOD), INP(7)};
                pg8::gemm_phase<pg8::EpiAda, true, 1>(lds, g, S, E);
                __syncthreads();
            }
            const int tsl = nF * 8 * 3 + nG * 8 * 2;
            prologue(a, lds, 1, gm ? nF * 24 + ((bx - nF) * 8 + wv_) * 2 : (bx * 8 + wv_) * 3, gm ? 2 : 3, tsl);
        } else if (ph == N_PHASES - 1) { if (EN(2)) final_phase(a); }
        else if (ph == 1) {}
        else {
            const int l = (ph - 2) / NSUB, s = (ph - 2) % NSUB;
            if (s == 0) { if (EN(3)) norm_phase(a, l, 0, l == 0); }
            else if ((s == 1 || s == 4) && EN(4)) {
                pg8::Gemm g{(const bf16_t*)(ws + WS_H), (const bf16_t*)(ws + WS_WIN) + (size_t)l * INC * D, D, D}; pg8::Order<1> S;
                if (s == 1) S.init(MP / 256, 11, G, bx, INC / 256, D / 64); else { S.init(MP / 256, 12, G, bx, 0, D / 64); S.pofs = 11; }
                pg8::EpiIn E{(float*)(ws + WS_QFK), (bf16_t*)(ws + WS_Z), (const float*)(ws + WS_LB) + l * 512};
                pg8::gemm_phase<pg8::EpiIn, true, 1>(lds, g, S, E);
            } else if (s == 2 && EN(5)) {
#ifndef REPA
#define REPA 0
#endif
                for (int rp = 0; rp <= ((REPA >> 0) & 1); ++rp)
                for (int u = bx; u < NBP * 4 * (NSPAN - 1); u += G) { const int bh = u / (NSPAN - 1), j = u % (NSPAN - 1); hgrn_unit<false>(a, lds, l, bh >> 2, bh & 3, j); }
                for (int rp = 0; rp <= ((REPA >> 1) & 1); ++rp)
                pool_phase(a, l);
                for (int rp = 0; rp <= ((REPA >> 2) & 1); ++rp)
                for (int u = G - 1 - bx; u < NBP * 16 * 4; u += G) gating_unit(a, lds, l, u);
                gating_sample(a, l);
                __syncthreads();
                for (int rp = 0; rp <= ((REPA >> 3) & 1); ++rp)
                for (int u = G - 1 - bx; u < MS * 4; u += G) hgrn_sample_unit(a, lds, l, u >> 2, u & 3);
            } else if (s == 3 && EN(6)) {
                for (int u = bx; u < NBP * 4 * NSPAN; u += G) { const int bh = u >> 3, j = u & 7; hgrn_unit<true>(a, lds, l, bh >> 2, bh & 3, j); }
            } else if (s == 5 && EN(7)) {
                pg8::Gemm g{(const bf16_t*)(ws + WS_MIX), (const bf16_t*)(ws + WS_WBR) + (size_t)l * D * D, D, D}; pg8::Order<1> S; S.init(MP / 256, D / 256, G, bx, 0, D / 64);
                bf16_t* Mb = (bf16_t*)(ws + WS_H); const bf16_t* Z = (const bf16_t*)(ws + WS_Z);
                pg8::EpiBranch E{Mb, Z};
                pg8::gemm_phase<pg8::EpiBranch, true, 1>(lds, g, S, E);
                sample_gemm_branch(lds, g.A + (size_t)MP * D, g.Bt, Mb, Z);
            } else if ((s == 6 || s == 9) && EN(8)) {
                const bool ff = (s == 9);
                const float* Gm = (const float*)(ws + WS_MOD) + l * NADA + (ff ? 5 : 2) * D;
                pg8::Gemm g; if (ff) g = pg8::Gemm{(const bf16_t*)(ws + WS_Z), (const bf16_t*)(ws + WS_WFO) + (size_t)l * D * FF, FF, FF}; else g = pg8::Gemm{(const bf16_t*)(ws + WS_H), (const bf16_t*)(ws + WS_WOUT) + (size_t)l * D * D, D, D};
                pg8::Order<1> S; S.init(MP / 256, D / 256, G, bx, 0, ff ? FF / 64 : D / 64);
                const bool src_in = (!ff && l == 0);
                pg8::EpiRes E{a.out, Gm, src_in ? INP(0) : a.out};
                pg8::gemm_phase<pg8::EpiRes, true, 1>(lds, g, S, E);
                SampEpiRes epi{a.out, Gm, src_in ? INP(1) : a.out + (size_t)MP * D};
                sample_gemm(lds, g.A + (size_t)MP * g.lda, g.lda, g.Bt, g.ldb, 0, ff ? FF : D, epi);
            } else if (s == 7) { if (EN(3)) norm_phase(a, l, 1, false); }
            else if (s == 8 && EN(9)) {
                pg8::Gemm g{(const bf16_t*)(ws + WS_H), (const bf16_t*)(ws + WS_WFI) + (size_t)l * 2 * FF * D, D, D}; pg8::Order<1> S; S.init(MP / 256, 2 * FF / 256, G, bx, 2 * FF / 256, D / 64);
                pg8::EpiFfn E{(bf16_t*)(ws + WS_Z)};
                pg8::gemm_phase<pg8::EpiFfn, true, 1>(lds, g, S, E);
            }
        }
        if (ph >= 2 && (ph - 2) % NSUB == 3) continue;
        if (ph + 1 < a.ph_hi) { if (ph == 0) grid.sync(); else xcd_barrier(xbar); }
#if defined(REPMASK)
        if (((REPMASK) >> ty_) & 1) { if (!rep_) { rep_ = 1; --ph; } else rep_ = 0; }
#endif
    }
}

#ifndef ONE_LAUNCH
#define ONE_LAUNCH 1
#endif
extern "C" void kernel_launch(void* const* d_in, const int* in_sizes, int n_in, void* d_out, int out_size, void* d_ws, size_t ws_size, hipStream_t stream) {
    static int grid = 0;
    if (grid == 0) {
        if (n_in != 24 || ws_size < WS_END) { fprintf(stderr, "kernel_launch: unexpected n_in %d or ws_size %zu (< %zu)\n", n_in, ws_size, (size_t)WS_END); grid = -1; return; }
        int dev = 0, cus = 0, per_cu = 0;
        hipGetDevice(&dev); hipDeviceGetAttribute(&cus, hipDeviceAttributeMultiprocessorCount, dev);
        if (hipFuncSetAttribute((const void*)fwd_kernel, hipFuncAttributeMaxDynamicSharedMemorySize, LDS_BYTES) != hipSuccess) { fprintf(stderr, "kernel_launch: hipFuncSetAttribute failed\n"); grid = -1; return; }
        if (hipOccupancyMaxActiveBlocksPerMultiprocessor(&per_cu, (const void*)fwd_kernel, 512, LDS_BYTES) != hipSuccess || per_cu < 1) { fprintf(stderr, "kernel_launch: occupancy query failed (%d)\n", per_cu); (void)hipGetLastError(); per_cu = 1; }
        grid = cus * (per_cu > 1 ? 1 : per_cu);
        fprintf(stderr, "kernel_launch: grid %d (cus %d, per_cu %d)\n", grid, cus, per_cu);
    }
    if (grid < 0) return;
    if (hipMemsetAsync((char*)d_ws + WS_CTL, 0, CTL_BYTES, stream) != hipSuccess) { fprintf(stderr, "kernel_launch: memset failed\n"); return; }
    Args a{};
    for (int i = 0; i < 24; ++i) a.in[i] = (const float*)d_in[i];
    a.out = (float*)d_out; a.ws = (unsigned char*)d_ws;
#if ONE_LAUNCH
    a.ph_lo = 0; a.ph_hi = N_PHASES;
    void* args[] = {&a};
    hipError_t e = hipLaunchCooperativeKernel((const void*)fwd_kernel, dim3(grid), dim3(512), args, LDS_BYTES, stream);
    if (e != hipSuccess) fprintf(stderr, "cooperative launch failed: %s (grid %d)\n", hipGetErrorString(e), grid);
#else
    for (int ph = 0; ph < N_PHASES; ++ph) {
        a.ph_lo = ph; a.ph_hi = ph + 1;
        hipLaunchKernelGGL(fwd_kernel, dim3(grid), dim3(512), LDS_BYTES, stream, a);
    }
#endif
}
```

```cpp
#include <hip/hip_runtime.h>
#include <hip/hip_cooperative_groups.h>
#include <cstdio>
#include <cstdint>
namespace cg = cooperative_groups;

#define LAS __attribute__((address_space(3)))
typedef unsigned short bf16_t;
typedef short bf16x8 __attribute__((ext_vector_type(8)));
typedef float f32x4 __attribute__((ext_vector_type(4)));
typedef float f32x2 __attribute__((ext_vector_type(2)));
typedef unsigned u32x4 __attribute__((ext_vector_type(4)));
typedef unsigned u32x2 __attribute__((ext_vector_type(2)));

constexpr int D = 1024, NBP = 8, SEQ = 2048, MP = NBP * SEQ, MS = 128, MV = MP + MS, MPAD = 16640, DEPTH = 4;
constexpr int INC = 5888, ZC = 4864, FF = 2816, NADA = 6 * D, NMOD = DEPTH * NADA, NMODROW = NBP + MS;
constexpr int ZV = 0, ZG = 512, ZP = 1024, ZU = 1280, ZVC = 1536, ZGATE = 1792;
constexpr int QFKC = 1536;
constexpr int QFKB = 3072, QFK_Q = 2048;
constexpr int NSPAN = 8, SPAN = SEQ / NSPAN;
constexpr size_t MiB = 1u << 20;
constexpr size_t WS_WADA = 0;
constexpr size_t WS_MIX = 0;
constexpr size_t WS_WIN = 48 * MiB;
constexpr size_t WS_WBR = 94 * MiB;
constexpr size_t WS_WOUT = 102 * MiB;
constexpr size_t WS_WFI = 110 * MiB;
constexpr size_t WS_WFO = 154 * MiB;
constexpr size_t WS_COND = 176 * MiB;
constexpr size_t WS_LB = 176 * MiB + 512 * 1024;
constexpr size_t WS_MOD = 177 * MiB;
constexpr size_t WS_H = 190 * MiB;
constexpr size_t WS_Z = 223 * MiB;
constexpr size_t WS_QFK = 378 * MiB;
constexpr size_t WS_U = 476 * MiB;
constexpr size_t WS_DU = 492 * MiB;
constexpr size_t WS_CTL = 493 * MiB;
constexpr size_t CTL_BYTES = 16384;
constexpr size_t WS_CWS = 493 * MiB + 65536;
constexpr size_t WS_END = 494 * MiB;
constexpr size_t O_Y = 0, O_HP = (size_t)MV * D, O_PP = O_HP + (size_t)DEPTH * NBP * 4 * 16384, O_HS = O_PP + (size_t)DEPTH * NBP * 15 * 256,
                 O_PS = O_HS + (size_t)DEPTH * MS * 4 * 16384, O_CV = O_PS + (size_t)DEPTH * MS * 15 * 256;
constexpr int LDS_BYTES = 147456;

__device__ __forceinline__ unsigned cvt_pk_bf16(float lo, float hi) { unsigned r; asm volatile("v_cvt_pk_bf16_f32 %0, %1, %2" : "=v"(r) : "v"(lo), "v"(hi)); return r; }
__device__ __forceinline__ float bf2f(unsigned h) { return __uint_as_float(h << 16); }
__device__ __forceinline__ float bflo(unsigned w) { return __uint_as_float(w << 16); }
__device__ __forceinline__ float bfhi(unsigned w) { return __uint_as_float(w & 0xffff0000u); }
__device__ __forceinline__ float sigmoidf_(float x) { return __builtin_amdgcn_rcpf(1.0f + __expf(-x)); }
__device__ __forceinline__ float siluf_(float x) { return x * sigmoidf_(x); }
__device__ __forceinline__ float geluf_(float x) { const float y = 1.5957691216057308f * (x + 0.044715f * x * x * x); return x * sigmoidf_(y); }
__device__ __forceinline__ float wave_sum(float v) {
#pragma unroll
    for (int o = 1; o < 64; o <<= 1) v += __shfl_xor(v, o);
    return v;
}
__device__ __forceinline__ int TID() { int t = threadIdx.x; asm volatile("" : "+v"(t)); return t; }
constexpr int PTR_TBL_OFF = 131072 + 1024;
__device__ __forceinline__ const float* INP(int k) {
    extern __shared__ __attribute__((aligned(16))) unsigned char lds_raw_[];
    const LAS unsigned* t = (const LAS unsigned*)((LAS unsigned char*)lds_raw_ + PTR_TBL_OFF) + 2 * k;
    const unsigned lo = __builtin_amdgcn_readfirstlane(t[0]), hi = __builtin_amdgcn_readfirstlane(t[1]);
    return (const float*)(((unsigned long long)hi << 32) | lo);
}
#define LDS_BAR() do { asm volatile("s_waitcnt lgkmcnt(0)" ::: "memory"); __builtin_amdgcn_s_barrier(); asm volatile("" ::: "memory"); } while (0)
__device__ __forceinline__ int mod_row(int r) { return r < MP ? (r >> 11) : (NBP + r - MP); }

namespace pg8 {
constexpr int BM = 256, BK = 64, HALF = 128, HTB = HALF * BK * 2, STAGE_BYTES = 8 * HTB, NXCD = 8, WGM = 8;
__host__ __device__ __forceinline__ int lds_byte(int r, int c) { const int st = (r >> 4) * 2 + (c >> 5), rr = r & 15, cc = c & 31, ob = rr * 64 + cc * 2; return st * 1024 + (ob ^ (((ob >> 9) & 1) << 5)); }
__host__ __device__ __forceinline__ void stage_rc(int b, int& R, int& C) { const int st = b / 1024, sb = b % 1024, swz = sb ^ (((sb >> 9) & 1) << 5); R = (st >> 1) * 16 + swz / 64; C = (st & 1) * 32 + (swz % 64) / 2; }
__host__ __device__ __forceinline__ int perm32(int rho) { const int n = rho >> 4, i = rho & 15; return 8 * (i >> 2) + 4 * n + (i & 3); }

struct Unit { int pm, pn, kofs, nt, sub; };
struct Gemm { const bf16_t* A; const bf16_t* Bt; int lda, ldb; };

template <int SUBS>
struct Order {
    int nM, nN, nwg, G, c, extra, nt0, pofs;
    __device__ void init(int nM_, int nN_, int G_, int c_, int extra_, int nt) { nM = nM_; nN = nN_; nwg = nM * nN; G = G_; c = c_; extra = extra_; nt0 = nt; pofs = 0; }
    __device__ bool next(int i, Unit& u) const {
        const int round = i / SUBS, sub = i - round * SUBS;
        const long L = (long)round * G + c;
        if (L >= nwg + extra) return false;
        u.sub = sub;
        if (SUBS == 3) { u.kofs = sub == 0 ? 0 : 256 + 256 * sub; u.nt = sub == 0 ? 8 : 4; } else { u.kofs = 0; u.nt = nt0; }
        if (L >= nwg) { u.pm = nM; u.pn = (int)(L - nwg); return true; }
        int wgid = (int)L; { const int q = nwg / NXCD, r = nwg % NXCD, xcd = wgid % NXCD, off = wgid / NXCD; wgid = (xcd < r ? xcd * (q + 1) : r * (q + 1) + (xcd - r) * q) + off; }
        const int nig = WGM * nN, gid = wgid / nig, fm = gid * WGM, gsz = (nM - fm) < WGM ? (nM - fm) : WGM;
        u.pm = fm + ((wgid % nig) % gsz); u.pn = pofs + (wgid % nig) / gsz; return true;
    }
};

template <class Epi, bool ALIGN_EPI, int SUBS>
__device__ __forceinline__ void gemm_phase(LAS unsigned char* lds, const Gemm g, const Order<SUBS>& S, const Epi& E) {
    const int tid = TID(), wid = __builtin_amdgcn_readfirstlane(tid >> 6), lane = tid & 63, wr = wid >> 2, wc = wid & 3, fr = lane & 15, fq = lane >> 4;
    unsigned voffA[2], voffB[2];
#pragma unroll
    for (int i = 0; i < 2; ++i) { int R, C; stage_rc(tid * 16 + i * 8192, R, C); const int Rb = Epi::PERM ? ((R & ~31) + perm32(R & 31)) : R;
        voffA[i] = (unsigned)(R * g.lda + C) * 2u; voffB[i] = (unsigned)(Rb * g.ldb + C) * 2u; }
    const size_t kstep = (size_t)(BK * 2);
    const size_t hstepA = (size_t)HALF * g.lda * 2, hstepB = (size_t)HALF * g.ldb * 2;
    const unsigned ldsw = (unsigned)wid * 1024u;
    const int aoff = lds_byte(wr * 64 + fr, fq * 8), boff = lds_byte(wc * 32 + fr, fq * 8);
#define PG8_SA(b, h) (((b) * 2 + (h)) * HTB)
#define PG8_SB(b, h) ((4 + (b) * 2 + (h)) * HTB)
#define PG8_STAGE(bufoff, gbase, voff) do { _Pragma("unroll") for (int _i = 0; _i < 2; ++_i) \
        __builtin_amdgcn_global_load_lds((const unsigned*)((const char*)(gbase) + (voff)[_i]), (LAS unsigned*)(lds + (bufoff) + ldsw + _i * 8192), 16, 0, 0); } while (0)
#define PG8_LDA(dst, b, h) do { _Pragma("unroll") for (int m = 0; m < 4; ++m) _Pragma("unroll") for (int k = 0; k < 2; ++k) dst[m][k] = *(const LAS bf16x8*)(lds + PG8_SA(b, h) + aoff + m * 2048 + k * 1024); } while (0)
#define PG8_LDB(dst, b, h) do { _Pragma("unroll") for (int n = 0; n < 2; ++n) _Pragma("unroll") for (int k = 0; k < 2; ++k) dst[n][k] = *(const LAS bf16x8*)(lds + PG8_SB(b, h) + boff + n * 2048 + k * 1024); } while (0)
#define PG8_MMA(ai, bj, At, Bt) do { __builtin_amdgcn_s_setprio(1); _Pragma("unroll") for (int m = 0; m < 4; ++m) _Pragma("unroll") for (int n = 0; n < 2; ++n) _Pragma("unroll") for (int k = 0; k < 2; ++k) \
        acc[ai][bj][m][n] = __builtin_amdgcn_mfma_f32_16x16x32_bf16(Bt[n][k], At[m][k], acc[ai][bj][m][n], 0, 0, 0); __builtin_amdgcn_s_setprio(0); } while (0)
#define PG8_WAIT_V(n) asm volatile("s_waitcnt vmcnt(" #n ")" ::: "memory")
#define PG8_WAIT_L(n) asm volatile("s_waitcnt lgkmcnt(" #n ")" ::: "memory")
#define PG8_BAR __builtin_amdgcn_s_barrier()
#define PG8_SCHED __builtin_amdgcn_sched_barrier(0)
    Unit cur, nxt; int ui = 0;
    if (!S.next(0, cur)) return;
    f32x4 acc[2][2][4][2];
#pragma unroll
    for (int a = 0; a < 2; ++a)
#pragma unroll
        for (int b = 0; b < 2; ++b)
#pragma unroll
            for (int m = 0; m < 4; ++m)
#pragma unroll
                for (int n = 0; n < 2; ++n) acc[a][b][m][n] = (f32x4){0.f, 0.f, 0.f, 0.f};
    bf16x8 At[4][2], B0[2][2], B1[2][2];
    const char* cA = (const char*)g.A + (size_t)cur.pm * 2 * hstepA + (size_t)cur.kofs * 2; const char* cB = (const char*)g.Bt + (size_t)cur.pn * 2 * hstepB + (size_t)cur.kofs * 2;
    PG8_STAGE(PG8_SB(0, 0), cB, voffB); PG8_STAGE(PG8_SB(0, 1), cB + hstepB, voffB); PG8_STAGE(PG8_SA(0, 0), cA, voffA); PG8_STAGE(PG8_SA(0, 1), cA + hstepA, voffA);
    if (wr == 1) PG8_BAR;
    PG8_WAIT_V(2); PG8_BAR;
    PG8_STAGE(PG8_SB(1, 0), cB + kstep, voffB); PG8_STAGE(PG8_SA(1, 0), cA + kstep, voffA); PG8_STAGE(PG8_SB(1, 1), cB + hstepB + kstep, voffB);
    PG8_WAIT_V(6); PG8_BAR;
    for (;;) {
        const bool has_next = S.next(ui + 1, nxt);
        const char* nA = has_next ? (const char*)g.A + (size_t)nxt.pm * 2 * hstepA + (size_t)nxt.kofs * 2 : cA; const char* nB = has_next ? (const char*)g.Bt + (size_t)nxt.pn * 2 * hstepB + (size_t)nxt.kofs * 2 : cB;
        const int nt = cur.nt;
        for (int t = 0; t < nt; t += 2) {
            if constexpr (Epi::MIDK) { if (t == 8 || t == 12) E.mid(acc, cur, t == 8 ? 0 : 1, wr, wc, fr, fq); }
            const bool last = (t == nt - 2);
            const char* a1 = cA + (size_t)(t + 1) * kstep;
            const char* a2 = last ? nA : cA + (size_t)(t + 2) * kstep; const char* b2 = last ? nB : cB + (size_t)(t + 2) * kstep;
            const char* a3 = a2 + kstep; const char* b3 = b2 + kstep;
            PG8_LDB(B0, 0, 0); PG8_LDB(B1, 0, 1); PG8_SCHED; PG8_LDA(At, 0, 0); PG8_STAGE(PG8_SA(1, 1), a1 + hstepA, voffA);
            PG8_WAIT_V(8); PG8_WAIT_L(0); PG8_BAR; PG8_MMA(0, 0, At, B0); PG8_MMA(0, 1, At, B1); PG8_BAR; PG8_SCHED;
            PG8_LDA(At, 0, 1); PG8_STAGE(PG8_SB(0, 0), b2, voffB); PG8_STAGE(PG8_SB(0, 1), b2 + hstepB, voffB); PG8_STAGE(PG8_SA(0, 0), a2, voffA);
            PG8_WAIT_V(8); PG8_WAIT_L(0); PG8_BAR; PG8_MMA(1, 0, At, B0); PG8_MMA(1, 1, At, B1); PG8_BAR; PG8_SCHED;
            PG8_LDB(B0, 1, 0); PG8_LDB(B1, 1, 1); PG8_SCHED; PG8_LDA(At, 1, 0); PG8_STAGE(PG8_SA(0, 1), a2 + hstepA, voffA);
            PG8_WAIT_V(8); PG8_WAIT_L(0); PG8_BAR; PG8_MMA(0, 0, At, B0); PG8_MMA(0, 1, At, B1); PG8_BAR; PG8_SCHED;
            PG8_LDA(At, 1, 1); PG8_STAGE(PG8_SB(1, 0), b3, voffB); PG8_STAGE(PG8_SB(1, 1), b3 + hstepB, voffB); PG8_STAGE(PG8_SA(1, 0), a3, voffA);
            PG8_WAIT_V(8); PG8_WAIT_L(0); PG8_BAR; PG8_MMA(1, 0, At, B0); PG8_MMA(1, 1, At, B1); PG8_BAR; PG8_SCHED;
        }
        if constexpr (ALIGN_EPI) { if (wr == 0) PG8_BAR; }
        E(acc, cur, wr, wc, fr, fq);
        if (!has_next) break;
#pragma unroll
        for (int a = 0; a < 2; ++a)
#pragma unroll
            for (int b = 0; b < 2; ++b)
#pragma unroll
                for (int m = 0; m < 4; ++m)
#pragma unroll
                    for (int n = 0; n < 2; ++n) acc[a][b][m][n] = (f32x4){0.f, 0.f, 0.f, 0.f};
        cur = nxt; cA = nA; cB = nB; ++ui;
        if constexpr (ALIGN_EPI) { if (wr == 1) PG8_BAR; }
    }
    PG8_WAIT_V(0);
    if constexpr (!ALIGN_EPI) { if (wr == 0) PG8_BAR; }
    PG8_BAR;
#undef PG8_SA
#undef PG8_SB
#undef PG8_STAGE
#undef PG8_LDA
#undef PG8_LDB
#undef PG8_MMA
#undef PG8_WAIT_V
#undef PG8_WAIT_L
#undef PG8_BAR
#undef PG8_SCHED
}

typedef f32x4 Acc[2][2][4][2];

struct EpiAda {
    static constexpr bool PERM = false, MIDK = false;
    float* MODp; const float* bias;
    __device__ __forceinline__ void operator()(const Acc& acc, const Unit& u, int wr, int wc, int fr, int fq) const {
        const int row0 = wr * 64 + fr, col0 = u.pn * BM + wc * 32 + 4 * fq;
#pragma unroll
        for (int ai = 0; ai < 2; ++ai)
#pragma unroll
            for (int m = 0; m < 4; ++m) { const int r = row0 + ai * HALF + m * 16; if (r < NMODROW) {
#pragma unroll
                for (int bj = 0; bj < 2; ++bj)
#pragma unroll
                    for (int n = 0; n < 2; ++n) { const int c = col0 + bj * HALF + n * 16; *(f32x4*)(MODp + (size_t)r * NMOD + c) = acc[ai][bj][m][n] + *(const f32x4*)(bias + c); } } }
    }
};

struct EpiIn {
    static constexpr bool PERM = true, MIDK = false;
    float* QFK; bf16_t* Z; const float* LB;
    __device__ __forceinline__ void operator()(const Acc& acc, const Unit& u, int wr, int wc, int fr, int fq) const {
        const int row0 = u.pm * BM + wr * 64 + fr, cb = wc * 32 + 8 * fq, pn = u.pn;
        if (pn < 2) {
#pragma unroll
            for (int ai = 0; ai < 2; ++ai)
#pragma unroll
                for (int m = 0; m < 4; ++m) { unsigned char* rp = (unsigned char*)QFK + (size_t)(row0 + ai * HALF + m * 16) * QFKB + QFK_Q + (pn * 256 + cb) * 2;
#pragma unroll
                    for (int bj = 0; bj < 2; ++bj) { const f32x4 v0 = acc[ai][bj][m][0], v1 = acc[ai][bj][m][1];
                        u32x4 w; w.x = cvt_pk_bf16(siluf_(v0[0]), siluf_(v0[1])); w.y = cvt_pk_bf16(siluf_(v0[2]), siluf_(v0[3])); w.z = cvt_pk_bf16(siluf_(v1[0]), siluf_(v1[1])); w.w = cvt_pk_bf16(siluf_(v1[2]), siluf_(v1[3]));
                        *(u32x4*)(rp + bj * HALF * 2) = w; } }
        } else if (pn < 4) {
            const int c0 = (pn - 2) * 256 + cb;
            f32x4 lb[2][2];
#pragma unroll
            for (int bj = 0; bj < 2; ++bj)
#pragma unroll
                for (int n = 0; n < 2; ++n) lb[bj][n] = *(const f32x4*)(LB + c0 + bj * HALF + 4 * n);
#pragma unroll
            for (int ai = 0; ai < 2; ++ai)
#pragma unroll
                for (int m = 0; m < 4; ++m) { unsigned char* rb = (unsigned char*)QFK + (size_t)(row0 + ai * HALF + m * 16) * QFKB;
#pragma unroll
                    for (int bj = 0; bj < 2; ++bj)
#pragma unroll
                        for (int n = 0; n < 2; ++n) { const f32x4 v = acc[ai][bj][m][n]; f32x4 ko;
#pragma unroll
                            for (int e = 0; e < 4; ++e) ko[e] = (1.0f - lb[bj][n][e]) * __builtin_amdgcn_rcpf(1.0f + __expf(v[e]));
                            *(f32x4*)(rb + (c0 + bj * HALF + 4 * n) * 4) = ko; } }
        } else {
            const int zc = (pn - 4) * 256 + cb;
            const int act = (pn < 6) ? 0 : (pn < 8) ? 1 : (pn == 8) ? 0 : (pn < 11) ? 2 : 3;
#pragma unroll
            for (int ai = 0; ai < 2; ++ai)
#pragma unroll
                for (int m = 0; m < 4; ++m) { bf16_t* rp = Z + (size_t)(row0 + ai * HALF + m * 16) * ZC + zc;
#pragma unroll
                    for (int bj = 0; bj < 2; ++bj) { f32x4 v0 = acc[ai][bj][m][0], v1 = acc[ai][bj][m][1];
                        if (act == 1) {
#pragma unroll
                            for (int e = 0; e < 4; ++e) { v0[e] = siluf_(v0[e]); v1[e] = siluf_(v1[e]); }
                        } else if (act == 2) {
#pragma unroll
                            for (int e = 0; e < 4; ++e) { v0[e] = geluf_(v0[e]); v1[e] = geluf_(v1[e]); }
                        } else if (act == 3) {
#pragma unroll
                            for (int e = 0; e < 4; ++e) { v0[e] = sigmoidf_(v0[e]); v1[e] = sigmoidf_(v1[e]); }
                        }
                        u32x4 w; w.x = cvt_pk_bf16(v0[0], v0[1]); w.y = cvt_pk_bf16(v0[2], v0[3]); w.z = cvt_pk_bf16(v1[0], v1[1]); w.w = cvt_pk_bf16(v1[2], v1[3]);
                        *(u32x4*)(rp + bj * HALF) = w; } }
        }
    }
};

struct EpiBranch {
    static constexpr bool PERM = true, MIDK = true;
    bf16_t* Mb; const bf16_t* Z;
    __device__ __forceinline__ void mid(Acc& acc, const Unit& u, int sub, int wr, int wc, int fr, int fq) const {
        const int row0 = u.pm * BM + wr * 64 + fr, col0 = u.pn * BM + wc * 32 + 8 * fq;
#pragma unroll
        for (int ai = 0; ai < 2; ++ai)
#pragma unroll
            for (int m = 0; m < 4; ++m) { const unsigned r = (unsigned)(row0 + ai * HALF + m * 16);
#pragma unroll
                for (int bj = 0; bj < 2; ++bj) { const int c = col0 + bj * HALF;
                    const unsigned bo = (r * ZC + ZGATE + sub * D + c) * 2u;
                    const u32x4 gn = *(const u32x4*)((const char*)Z + bo), gd = *(const u32x4*)((const char*)Z + bo + 2 * D);
                    f32x4& v0 = acc[ai][bj][m][0]; f32x4& v1 = acc[ai][bj][m][1];
                    v0[0] *= bflo(gn.x) * __builtin_amdgcn_rcpf(bflo(gd.x)); v0[1] *= bfhi(gn.x) * __builtin_amdgcn_rcpf(bfhi(gd.x)); v0[2] *= bflo(gn.y) * __builtin_amdgcn_rcpf(bflo(gd.y)); v0[3] *= bfhi(gn.y) * __builtin_amdgcn_rcpf(bfhi(gd.y));
                    v1[0] *= bflo(gn.z) * __builtin_amdgcn_rcpf(bflo(gd.z)); v1[1] *= bfhi(gn.z) * __builtin_amdgcn_rcpf(bfhi(gd.z)); v1[2] *= bflo(gn.w) * __builtin_amdgcn_rcpf(bflo(gd.w)); v1[3] *= bfhi(gn.w) * __builtin_amdgcn_rcpf(bfhi(gd.w)); }
                asm volatile("" ::: "memory"); }
    }
    __device__ __forceinline__ void operator()(const Acc& acc, const Unit& u, int wr, int wc, int fr, int fq) const {
        const int row0 = u.pm * BM + wr * 64 + fr, col0 = u.pn * BM + wc * 32 + 8 * fq;
#pragma unroll
        for (int ai = 0; ai < 2; ++ai)
#pragma unroll
            for (int m = 0; m < 4; ++m) { const unsigned r = (unsigned)(row0 + ai * HALF + m * 16);
#pragma unroll
                for (int bj = 0; bj < 2; ++bj) { const int c = col0 + bj * HALF;
                    const u32x4 gw = *(const u32x4*)((const char*)Z + (r * ZC + ZGATE + 2 * D + c) * 2u);
                    const f32x4 v0 = acc[ai][bj][m][0], v1 = acc[ai][bj][m][1];
                    u32x4 w;
                    w.x = cvt_pk_bf16(bflo(gw.x) * v0[0], bfhi(gw.x) * v0[1]); w.y = cvt_pk_bf16(bflo(gw.y) * v0[2], bfhi(gw.y) * v0[3]);
                    w.z = cvt_pk_bf16(bflo(gw.z) * v1[0], bfhi(gw.z) * v1[1]); w.w = cvt_pk_bf16(bflo(gw.w) * v1[2], bfhi(gw.w) * v1[3]);
                    *(u32x4*)((char*)Mb + (r * D + c) * 2u) = w; }
                asm volatile("" ::: "memory"); }
    }
};

struct EpiRes {
    static constexpr bool PERM = false, MIDK = false;
    float* X; const float* G; const float* XS;
    __device__ __forceinline__ void operator()(const Acc& acc, const Unit& u, int wr, int wc, int fr, int fq) const {
        const int row0 = u.pm * BM + wr * 64 + fr, col0 = u.pn * BM + wc * 32 + 4 * fq;
        const float* gp = G + (size_t)(u.pm >> 3) * NMOD + col0;
        f32x4 gv[2][2];
#pragma unroll
        for (int bj = 0; bj < 2; ++bj)
#pragma unroll
            for (int n = 0; n < 2; ++n) gv[bj][n] = *(const f32x4*)(gp + bj * HALF + n * 16);
#pragma unroll
        for (int ai = 0; ai < 2; ++ai)
#pragma unroll
            for (int m = 0; m < 4; ++m) { const size_t ro = (size_t)(row0 + ai * HALF + m * 16) * D + col0;
#pragma unroll
                for (int bj = 0; bj < 2; ++bj)
#pragma unroll
                    for (int n = 0; n < 2; ++n) { const size_t o = ro + bj * HALF + n * 16; *(f32x4*)(X + o) = *(const f32x4*)(XS + o) + gv[bj][n] * acc[ai][bj][m][n]; } }
    }
};

struct EpiFfn {
    static constexpr bool PERM = true, MIDK = false;
    bf16_t* ACT;
    __device__ __forceinline__ void operator()(const Acc& acc, const Unit& u, int wr, int wc, int fr, int fq) const {
        const int row0 = u.pm * BM + wr * 64 + fr, col0 = u.pn * HALF + wc * 32 + 8 * fq;
#pragma unroll
        for (int ai = 0; ai < 2; ++ai)
#pragma unroll
            for (int m = 0; m < 4; ++m) { bf16_t* rp = ACT + (size_t)(row0 + ai * HALF + m * 16) * FF + col0;
                const f32x4 g0 = acc[ai][0][m][0], g1 = acc[ai][0][m][1], u0 = acc[ai][1][m][0], u1 = acc[ai][1][m][1];
                u32x4 w; w.x = cvt_pk_bf16(siluf_(g0[0]) * u0[0], siluf_(g0[1]) * u0[1]); w.y = cvt_pk_bf16(siluf_(g0[2]) * u0[2], siluf_(g0[3]) * u0[3]);
                w.z = cvt_pk_bf16(siluf_(g1[0]) * u1[0], siluf_(g1[1]) * u1[1]); w.w = cvt_pk_bf16(siluf_(g1[2]) * u1[2], siluf_(g1[3]) * u1[3]);
                *(u32x4*)rp = w; }
    }
};
}

template <class F>
__device__ __forceinline__ void sample_gemm(LAS unsigned char* lds, const bf16_t* A  , int lda, const bf16_t* Bt, int ldb, int kofs, int K, const F& epi) {
    const int tid = TID(), wid = __builtin_amdgcn_readfirstlane(tid >> 6), lane = tid & 63, fr = lane & 15, fq = lane >> 4;
    LAS f32x4* red = (LAS f32x4*)lds;
    const int kw = K / 8;
    for (int it = blockIdx.x; it < 256; it += gridDim.x) {
        const int rb = it >> 6, cbk = it & 63;
        f32x4 a0 = (f32x4){0.f, 0.f, 0.f, 0.f}, a1 = a0;
        typename F::Pre pre[4];
        if (tid < 128) {
#pragma unroll
            for (int i = 0; i < 4; ++i) pre[i] = epi.pre(rb * 32 + (tid >> 6) * 16 + 4 * fq + i, cbk * 16 + fr); }
        const bf16_t* ap = A + (size_t)(rb * 32 + fr) * lda + kofs + wid * kw + 8 * fq;
        const bf16_t* bp = Bt + (size_t)(cbk * 16 + fr) * ldb + kofs + wid * kw + 8 * fq;
        for (int k = 0; k < kw; k += 128) {
            bf16x8 av0[4], av1[4], bv[4];
#pragma unroll
            for (int q = 0; q < 4; ++q) if (k + 32 * q < kw) { av0[q] = *(const bf16x8*)(ap + k + 32 * q); av1[q] = *(const bf16x8*)(ap + (size_t)16 * lda + k + 32 * q); bv[q] = *(const bf16x8*)(bp + k + 32 * q); }
#pragma unroll
            for (int q = 0; q < 4; ++q) if (k + 32 * q < kw) { a0 = __builtin_amdgcn_mfma_f32_16x16x32_bf16(av0[q], bv[q], a0, 0, 0, 0); a1 = __builtin_amdgcn_mfma_f32_16x16x32_bf16(av1[q], bv[q], a1, 0, 0, 0); }
        }
        __syncthreads();
        red[(wid * 2 + 0) * 64 + lane] = a0; red[(wid * 2 + 1) * 64 + lane] = a1;
        __syncthreads();
        if (tid < 128) {
            const int mt = tid >> 6; f32x4 s = (f32x4){0.f, 0.f, 0.f, 0.f};
#pragma unroll
            for (int w = 0; w < 8; ++w) s += red[(w * 2 + mt) * 64 + lane];
            const int col = cbk * 16 + fr, rowb = rb * 32 + mt * 16 + 4 * fq;
#pragma unroll
            for (int i = 0; i < 4; ++i) epi(rowb + i, col, s[i], pre[i]);
        }
    }
    __syncthreads();
}

struct SampEpiRes { float* X; const float* Gm; const float* XS;
    typedef f32x2 Pre;
    __device__ __forceinline__ Pre pre(int r, int c) const { return (f32x2){XS[(size_t)r * D + c], Gm[(size_t)(NBP + r) * NMOD + c]}; }
    __device__ __forceinline__ void operator()(int r, int c, float v, Pre p) const { X[(size_t)(MP + r) * D + c] = p.x + p.y * v; } };

__device__ __forceinline__ void sample_gemm_branch(LAS unsigned char* lds, const bf16_t* A, const bf16_t* Bt, bf16_t* Mb, const bf16_t* Z) {
    const int tid = TID(), wid = __builtin_amdgcn_readfirstlane(tid >> 6), lane = tid & 63, fr = lane & 15, fq = lane >> 4;
    LAS f32x4* red = (LAS f32x4*)lds;
    for (int it = blockIdx.x; it < 256; it += gridDim.x) {
        const int rb = it >> 6, cbk = it & 63;
        f32x4 a0 = (f32x4){0.f, 0.f, 0.f, 0.f}, a1 = a0;
        const bf16_t* ap = A + (size_t)(rb * 32 + fr) * D + wid * 128 + 8 * fq;
        const bf16_t* bp = Bt + (size_t)(cbk * 16 + fr) * D + wid * 128 + 8 * fq;
        bf16x8 av0[4], av1[4], bv[4];
#pragma unroll
        for (int q = 0; q < 4; ++q) { av0[q] = *(const bf16x8*)(ap + 32 * q); av1[q] = *(const bf16x8*)(ap + (size_t)16 * D + 32 * q); bv[q] = *(const bf16x8*)(bp + 32 * q); }
        const int mt = tid >> 6, col = cbk * 16 + fr, rowb = rb * 32 + (mt & 1) * 16 + 4 * fq;
        unsigned short gt[4][3];
        if (tid < 128) {
#pragma unroll
            for (int i = 0; i < 4; ++i)
#pragma unroll
                for (int sb = 0; sb < 3; ++sb) gt[i][sb] = Z[(size_t)(MP + rowb + i) * ZC + ZGATE + sb * D + col]; }
#pragma unroll
        for (int q = 0; q < 4; ++q) { a0 = __builtin_amdgcn_mfma_f32_16x16x32_bf16(av0[q], bv[q], a0, 0, 0, 0); a1 = __builtin_amdgcn_mfma_f32_16x16x32_bf16(av1[q], bv[q], a1, 0, 0, 0); }
        __syncthreads();
        red[(wid * 2 + 0) * 64 + lane] = a0; red[(wid * 2 + 1) * 64 + lane] = a1;
        __syncthreads();
        if (tid < 128) {
            const f32x4 ya = (red[(0 * 2 + mt) * 64 + lane] + red[(1 * 2 + mt) * 64 + lane]) + (red[(2 * 2 + mt) * 64 + lane] + red[(3 * 2 + mt) * 64 + lane]);
            const f32x4 yb = red[(4 * 2 + mt) * 64 + lane] + red[(5 * 2 + mt) * 64 + lane];
            const f32x4 yc = red[(6 * 2 + mt) * 64 + lane] + red[(7 * 2 + mt) * 64 + lane];
#pragma unroll
            for (int i = 0; i < 4; ++i) { const float v = bf2f(gt[i][0]) * ya[i] + bf2f(gt[i][1]) * yb[i] + bf2f(gt[i][2]) * yc[i];
                Mb[(size_t)(MP + rowb + i) * D + col] = (bf16_t)(cvt_pk_bf16(v, 0.f) & 0xffffu); }
        }
    }
    __syncthreads();
}

__device__ __forceinline__ void transpose_item(const float* W, int N, bf16_t* WT, int ldt, int k0, int n0, int drow0, LAS float* scr, int lane) {
    float tv[32];
#pragma unroll
    for (int i = 0; i < 32; ++i) { const int kk = 2 * i + (lane >> 5); tv[i] = __builtin_nontemporal_load(W + (size_t)(k0 + kk) * N + n0 + (lane & 31)); }
#pragma unroll
    for (int i = 0; i < 32; ++i) { const int kk = 2 * i + (lane >> 5); scr[kk * 33 + (lane & 31)] = tv[i]; }
    asm volatile("s_waitcnt lgkmcnt(0)" ::: "memory");
    const int c = lane & 7;
#pragma unroll
    for (int j = 0; j < 4; ++j) { const int n = (lane >> 3) + 8 * j; const LAS float* s = scr + (8 * c) * 33 + n;
        u32x4 o; o.x = cvt_pk_bf16(s[0 * 33], s[1 * 33]); o.y = cvt_pk_bf16(s[2 * 33], s[3 * 33]); o.z = cvt_pk_bf16(s[4 * 33], s[5 * 33]); o.w = cvt_pk_bf16(s[6 * 33], s[7 * 33]);
        *(u32x4*)(WT + (size_t)(drow0 + n) * ldt + k0 + 8 * c) = o; }
    asm volatile("s_waitcnt lgkmcnt(0)" ::: "memory");
}

struct Args { const float* in[24]; float* out; unsigned char* ws; int ph_lo, ph_hi; };

__device__ __forceinline__ void prologue(const Args& a, LAS unsigned char* lds, int part, int slot0, int nslots, int tslots) {
    const int tid = TID(), lane = tid & 63, wave = __builtin_amdgcn_readfirstlane(tid >> 6);
    const int G = gridDim.x, gw = blockIdx.x * 8 + wave, NGW = G * 8;
    unsigned char* ws = a.ws;
    LAS float* scr = (LAS float*)(lds + wave * 16384);
    constexpr int I_ADA = 16 * 192, I_IN = 16 * 184, I_BA = 8 * 32, I_BC = 4 * 32, I_O = 16 * 32, I_FI = 16 * 176, I_FO = 44 * 32;
    constexpr int I_L = I_ADA + I_IN + I_BA + I_BC + I_O + I_FI + I_FO;
    if (part == 0) {
        for (int it = gw; it < DEPTH * I_ADA; it += NGW) { const int l = it / I_ADA, r = it - l * I_ADA; const int kb = r / 192, nb = r % 192;
            transpose_item(INP(6) + (size_t)l * D * NADA, NADA, (bf16_t*)(ws + WS_WADA) + (size_t)l * NADA * D, D, kb * 64, nb * 32, nb * 32, scr, lane); }
    } else
    for (int sl = slot0; sl < slot0 + nslots; ++sl)
    for (int it = sl; it < DEPTH * (I_L - I_ADA); it += tslots) {
        const int lq = it / (I_L - I_ADA), l = DEPTH - 1 - lq; int r = it - lq * (I_L - I_ADA) + I_ADA;
        if (r < I_ADA) { const int kb = r / 192, nb = r % 192; transpose_item(INP(6) + (size_t)l * D * NADA, NADA, (bf16_t*)(ws + WS_WADA) + (size_t)l * NADA * D, D, kb * 64, nb * 32, nb * 32, scr, lane); continue; } r -= I_ADA;
        if (r < I_IN) { const int kb = r / 184, nb = r % 184; transpose_item(INP(8) + (size_t)l * D * INC, INC, (bf16_t*)(ws + WS_WIN) + (size_t)l * INC * D, D, kb * 64, nb * 32, nb * 32, scr, lane); continue; } r -= I_IN;
        if (r < I_BA) { const int kb = r / 32, nb = r % 32; transpose_item(INP(17) + (size_t)l * 512 * D, D, (bf16_t*)(ws + WS_WBR) + (size_t)l * D * D, D, kb * 64, nb * 32, nb * 32, scr, lane); continue; } r -= I_BA;
        if (r < I_BC) { const int kb = r / 32, nb = r % 32; transpose_item(INP(19) + (size_t)l * 256 * D, D, (bf16_t*)(ws + WS_WBR) + (size_t)l * D * D + 768, D, kb * 64, nb * 32, nb * 32, scr, lane); continue; } r -= I_BC;
        if (r < I_O) { const int kb = r / 32, nb = r % 32; transpose_item(INP(20) + (size_t)l * D * D, D, (bf16_t*)(ws + WS_WOUT) + (size_t)l * D * D, D, kb * 64, nb * 32, nb * 32, scr, lane); continue; } r -= I_O;
        if (r < I_FI) { const int kb = r / 176, nb = r % 176; const int n0 = nb * 32; const int cc = n0 < FF ? n0 : n0 - FF; const int dr = (cc >> 7) * 256 + (n0 < FF ? 0 : 128) + (cc & 127);
            transpose_item(INP(21) + (size_t)l * D * 2 * FF, 2 * FF, (bf16_t*)(ws + WS_WFI) + (size_t)l * 2 * FF * D, D, kb * 64, n0, dr, scr, lane); continue; } r -= I_FI;
        { const int kb = r / 32, nb = r % 32; transpose_item(INP(22) + (size_t)l * FF * D, D, (bf16_t*)(ws + WS_WFO) + (size_t)l * D * FF, FF, kb * 64, nb * 32, nb * 32, scr, lane); }
    }
    if (part == 1)
    for (int it = gw; it < DEPTH * 4 * 16 * 8; it += NGW) {
        const int l = it >> 9, g = (it >> 7) & 3, nblk = (it >> 3) & 15, c8 = it & 7, n = nblk * 64 + lane;
        const float* mp = INP(11) + ((size_t)(l * 4 + g) * 64 + c8 * 8) * 64; const float* sc = INP(12) + l * 256 + g * 64; const float* wb = INP(18) + ((size_t)l * 256 + g * 64) * D + n;
        float acc[8];
#pragma unroll
        for (int j = 0; j < 8; ++j) acc[j] = 0.f;
        for (int d0 = 0; d0 < 64; d0 += 16) { float wv[16];
#pragma unroll
            for (int dd = 0; dd < 16; ++dd) wv[dd] = wb[(size_t)(d0 + dd) * D];
#pragma unroll
            for (int dd = 0; dd < 16; ++dd) { const float w = wv[dd] * sc[d0 + dd];
#pragma unroll
                for (int j = 0; j < 8; ++j) acc[j] += mp[j * 64 + d0 + dd] * w; } }
        u32x4 o; o.x = cvt_pk_bf16(acc[0], acc[1]); o.y = cvt_pk_bf16(acc[2], acc[3]); o.z = cvt_pk_bf16(acc[4], acc[5]); o.w = cvt_pk_bf16(acc[6], acc[7]);
        *(u32x4*)((bf16_t*)(ws + WS_WBR) + (size_t)l * D * D + (size_t)n * D + 512 + g * 64 + c8 * 8) = o;
    }
    if (part == 1) { bf16_t* Wc = (bf16_t*)(ws + WS_CWS); const float* src = INP(15);
      for (int i = blockIdx.x * 512 + tid; i < DEPTH * 4 * 128 * 128 / 4; i += G * 512) { const int e = i * 4, t = (e >> 7) & 127, s0 = e & 127; const f32x4 v = *(const f32x4*)(src + e);
          u32x2 o; o.x = cvt_pk_bf16(s0 <= t ? v[0] : 0.f, s0 + 1 <= t ? v[1] : 0.f); o.y = cvt_pk_bf16(s0 + 2 <= t ? v[2] : 0.f, s0 + 3 <= t ? v[3] : 0.f); *(u32x2*)(Wc + e) = o; } }
    if (part == 0) { bf16_t* C = (bf16_t*)(ws + WS_COND);
      for (int i = blockIdx.x * 512 + tid; i < 256 * D / 4; i += G * 512) { const int row = i >> 8, c4 = (i & 255) * 4; f32x4 v = (f32x4){0.f, 0.f, 0.f, 0.f};
          if (row < NBP) v = *(const f32x4*)(INP(4) + (size_t)row * D + c4); else if (row < NMODROW) v = *(const f32x4*)(INP(5) + (size_t)(row - NBP) * D + c4);
          u32x2 o; o.x = cvt_pk_bf16(siluf_(v[0]), siluf_(v[1])); o.y = cvt_pk_bf16(siluf_(v[2]), siluf_(v[3])); *(u32x2*)(C + (size_t)row * D + c4) = o; } }
    if (part == 0 && blockIdx.x == 0) { float* LB = (float*)(ws + WS_LB); const float* lg = INP(9); const int k = tid;
        const float x0 = lg[k], x1 = lg[512 + k], x2 = lg[1024 + k], x3 = lg[1536 + k]; const float mx = fmaxf(fmaxf(x0, x1), fmaxf(x2, x3));
        const float e0 = expf(x0 - mx), e1 = expf(x1 - mx), e2 = expf(x2 - mx), e3 = expf(x3 - mx), inv = 1.0f / (e0 + e1 + e2 + e3);
        LB[k] = 0.f; LB[512 + k] = fmaxf(e1 * inv, 0.f); LB[1024 + k] = fmaxf((e1 + e2) * inv, 0.f); LB[1536 + k] = fmaxf((e1 + e2 + e3) * inv, 0.f); }
}

__device__ __forceinline__ void norm_phase(const Args& a, int l, int which, bool first) {
    const int tid_ = TID(), lane = tid_ & 63, wave = tid_ >> 6, gw = blockIdx.x * 8 + wave, NGW = gridDim.x * 8;
    float* X = a.out; bf16_t* H = (bf16_t*)(a.ws + WS_H); const float* MODp = (const float*)(a.ws + WS_MOD) + l * NADA + which * 3 * D;
    const float* xp = INP(0); const float* xs = INP(1);
    for (int rb = gw; rb < MV; rb += 4 * NGW) {
        f32x4 v[4][4]; float s[4];
#pragma unroll
        for (int q = 0; q < 4; ++q) { const int r = rb + q * NGW; s[q] = 0.f;
            if (r < MV) { const float* xr = first ? (r < MP ? xp + (size_t)r * D : xs + (size_t)(r - MP) * D) : X + (size_t)r * D;
#pragma unroll
                for (int j = 0; j < 4; ++j) v[q][j] = *(const f32x4*)(xr + 4 * lane + 256 * j); }
            else {
#pragma unroll
                for (int j = 0; j < 4; ++j) v[q][j] = (f32x4){0.f, 0.f, 0.f, 0.f}; } }
#pragma unroll
        for (int q = 0; q < 4; ++q)
#pragma unroll
            for (int j = 0; j < 4; ++j) s[q] += (v[q][j][0] * v[q][j][0] + v[q][j][1] * v[q][j][1]) + (v[q][j][2] * v[q][j][2] + v[q][j][3] * v[q][j][3]);
#pragma unroll
        for (int o = 1; o < 64; o <<= 1) {
#pragma unroll
            for (int q = 0; q < 4; ++q) s[q] += __shfl_xor(s[q], o); }
#pragma unroll
        for (int q = 0; q < 4; ++q) { const int r = rb + q * NGW; if (r < MV) {
            const float rstd = rsqrtf(s[q] * (1.0f / D) + 1e-6f);
            const float* mr = MODp + (size_t)mod_row(r) * NMOD;
#pragma unroll
            for (int j = 0; j < 4; ++j) { const int c = 4 * lane + 256 * j; const f32x4 sh = *(const f32x4*)(mr + c), sc = *(const f32x4*)(mr + D + c); const f32x4 o = v[q][j] * rstd * (sc + 1.0f) + sh;
                u32x2 w; w.x = cvt_pk_bf16(o[0], o[1]); w.y = cvt_pk_bf16(o[2], o[3]); *(u32x2*)(H + (size_t)r * D + c) = w; } } }
    }
}
__device__ __forceinline__ void final_phase(const Args& a) {
    const int tid_ = TID(), lane = tid_ & 63, wave = tid_ >> 6, gw = blockIdx.x * 8 + wave, NGW = gridDim.x * 8;
    float* X = a.out; const float* fg = INP(23);
    f32x4 fgv[4];
#pragma unroll
    for (int j = 0; j < 4; ++j) fgv[j] = *(const f32x4*)(fg + 4 * lane + 256 * j);
    for (int rb = gw; rb < MV; rb += 4 * NGW) {
        f32x4 v[4][4]; float s[4];
#pragma unroll
        for (int q = 0; q < 4; ++q) { const int r = rb + q * NGW; s[q] = 0.f;
#pragma unroll
            for (int j = 0; j < 4; ++j) v[q][j] = (r < MV) ? *(const f32x4*)(X + (size_t)r * D + 4 * lane + 256 * j) : (f32x4){0.f, 0.f, 0.f, 0.f}; }
#pragma unroll
        for (int q = 0; q < 4; ++q)
#pragma unroll
            for (int j = 0; j < 4; ++j) s[q] += (v[q][j][0] * v[q][j][0] + v[q][j][1] * v[q][j][1]) + (v[q][j][2] * v[q][j][2] + v[q][j][3] * v[q][j][3]);
#pragma unroll
        for (int o = 1; o < 64; o <<= 1) {
#pragma unroll
            for (int q = 0; q < 4; ++q) s[q] += __shfl_xor(s[q], o); }
#pragma unroll
        for (int q = 0; q < 4; ++q) { const int r = rb + q * NGW; if (r < MV) { const float rstd = rsqrtf(s[q] * (1.0f / D) + 1e-6f);
#pragma unroll
            for (int j = 0; j < 4; ++j) *(f32x4*)(X + (size_t)r * D + 4 * lane + 256 * j) = v[q][j] * rstd * fgv[j]; } }
    }
}

typedef __bf16 bf16x2_t __attribute__((ext_vector_type(2)));
__device__ __forceinline__ unsigned cvtpk(float lo, float hi) { f32x2 v = {lo, hi}; bf16x2_t b = __builtin_convertvector(v, bf16x2_t); return __builtin_bit_cast(unsigned, b); }
constexpr int HQ_P = 136, HK_P = 24, HO_P = 132;
template <bool PASS3>
__device__ __forceinline__ void hgrn_unit(const Args& a, LAS unsigned char* lds, int l, int b, int h, int j) {
    const int tid = TID(), lane = tid & 63, w = __builtin_amdgcn_readfirstlane(tid >> 6), c16 = lane & 15, g = lane >> 4;
    LAS bf16_t* QT = (LAS bf16_t*)lds;
    LAS bf16_t* KT = QT + 16 * HQ_P;
    LAS bf16_t* KH = KT + 16 * HQ_P;
    LAS bf16_t* VT = KH + 128 * HK_P;
    LAS float* DD = (LAS float*)(VT + 128 * HK_P);
    LAS float* TOT = DD + 128;
    LAS float* OB = TOT + 512;
    const float* QFK = (const float*)(a.ws + WS_QFK); const bf16_t* Z = (const bf16_t*)(a.ws + WS_Z);
    float* U = (float*)(a.ws + WS_U); float* DU = (float*)(a.ws + WS_DU);
    const int bh = b * 4 + h, t0 = b * SEQ + j * SPAN;
    const int pk = tid & 127, tq = tid >> 7;
    f32x4 S[8];
#pragma unroll
    for (int kt = 0; kt < 8; ++kt) S[kt] = (f32x4){0.f, 0.f, 0.f, 0.f};
    if (PASS3) {
        for (int jj = 0; jj < j; ++jj) { const float* up = U + (size_t)(bh * NSPAN + jj) * 16384 + (size_t)w * 2048 + lane * 4; const float* dp = DU + (size_t)(bh * NSPAN + jj) * 128;
#pragma unroll
            for (int kt = 0; kt < 8; ++kt) { const f32x4 dd = *(const f32x4*)(dp + 16 * kt + 4 * g);
                S[kt] = dd * S[kt] + *(const f32x4*)(up + kt * 256); } }
    }
    float bsum = 0.f;
    float rfA[2][4], rqA[2][4], rkA[2][4]; unsigned rvA[2][4];
#pragma unroll
    for (int pp = 0; pp < 2; ++pp)
#pragma unroll
        for (int i = 0; i < 4; ++i) { const size_t row = (size_t)(t0 + pp * 16 + 4 * tq + i); const unsigned char* bp = (const unsigned char*)QFK + row * QFKB; if (PASS3) rqA[pp][i] = bf2f(*(const bf16_t*)(bp + QFK_Q + (h * 128 + pk) * 2)); rkA[pp][i] = *(const float*)(bp + (h * 128 + pk) * 4); rfA[pp][i] = fmaxf(1.0f - rkA[pp][i], 1e-30f); rvA[pp][i] = Z[row * ZC + ZV + h * 128 + pk]; }
    const int tt_n = tid >> 5, c4_n = (tid & 31) * 4;
    f32x4 gn = (f32x4){0.f, 0.f, 0.f, 0.f};
    if (PASS3) gn = *(const f32x4*)(INP(10) + (size_t)l * 512 + h * 128 + c4_n);
    for (int blk2 = 0; blk2 < SPAN / 32; ++blk2)
#pragma unroll
    for (int par = 0; par < 2; ++par) {
        const int blk = 2 * blk2 + par;
        float (&rf)[4] = rfA[par]; float (&rq)[4] = rqA[par]; float (&rk)[4] = rkA[par]; unsigned (&rv)[4] = rvA[par];
        u32x2 gg = (u32x2){0u, 0u};
        if (PASS3) gg = *(const u32x2*)(Z + (size_t)(t0 + blk * 16 + tt_n) * ZC + ZG + h * 128 + c4_n);
        float p[4]; { float acc = 0.f;
#pragma unroll
            for (int i = 0; i < 4; ++i) { acc += __logf(rf[i]); p[i] = acc; } }
        TOT[tq * 128 + pk] = p[3];
        LDS_BAR();
        {
            const float t0_ = TOT[pk], t1_ = TOT[128 + pk], t2_ = TOT[256 + pk], t3_ = TOT[384 + pk];
            const float off = tq == 0 ? 0.f : tq == 1 ? t0_ : tq == 2 ? t0_ + t1_ : (t0_ + t1_) + t2_;
            const float b15 = (t0_ + t1_) + (t2_ + t3_);
            float kh[4];
#pragma unroll
            for (int i = 0; i < 4; ++i) { const float bb = off + p[i]; const int t = 4 * tq + i;
                if (PASS3) { const float e = __expf(bb); QT[t * HQ_P + pk] = (bf16_t)(cvtpk(rq[i] * e, 0.f) & 0xffffu); KT[t * HQ_P + pk] = (bf16_t)(cvtpk(rk[i] * __expf(-bb), 0.f) & 0xffffu); }
                kh[i] = rk[i] * __expf(b15 - bb); }
            *(LAS u32x2*)(KH + pk * HK_P + 4 * tq) = (u32x2){cvtpk(kh[0], kh[1]), cvtpk(kh[2], kh[3])};
            *(LAS u32x2*)(VT + pk * HK_P + 4 * tq) = (u32x2){rv[0] | (rv[1] << 16), rv[2] | (rv[3] << 16)};
            if (tq == 0) { DD[pk] = __expf(b15); bsum += b15; }
        }
        if (blk + 2 < SPAN / 16) {
#pragma unroll
            for (int i = 0; i < 4; ++i) { const size_t row = (size_t)(t0 + (blk + 2) * 16 + 4 * tq + i); const unsigned char* bp = (const unsigned char*)QFK + row * QFKB; if (PASS3) rq[i] = bf2f(*(const bf16_t*)(bp + QFK_Q + (h * 128 + pk) * 2)); rk[i] = *(const float*)(bp + (h * 128 + pk) * 4); rf[i] = fmaxf(1.0f - rk[i], 1e-30f); rv[i] = Z[row * ZC + ZV + h * 128 + pk]; }
        }
        LDS_BAR();
        {
            const bf16x8 zero8 = (bf16x8){0, 0, 0, 0, 0, 0, 0, 0};
            if (PASS3) {
                f32x4 oT = (f32x4){0.f, 0.f, 0.f, 0.f}, AT = (f32x4){0.f, 0.f, 0.f, 0.f};
#pragma unroll
                for (int s2 = 0; s2 < 4; ++s2) {
                    const u32x4 aw = (u32x4){cvtpk(S[2 * s2][0], S[2 * s2][1]), cvtpk(S[2 * s2][2], S[2 * s2][3]), cvtpk(S[2 * s2 + 1][0], S[2 * s2 + 1][1]), cvtpk(S[2 * s2 + 1][2], S[2 * s2 + 1][3])};
                    const u32x2 q0 = *(const LAS u32x2*)(QT + c16 * HQ_P + 32 * s2 + 4 * g), q1 = *(const LAS u32x2*)(QT + c16 * HQ_P + 32 * s2 + 16 + 4 * g);
                    const u32x4 bw = (u32x4){q0.x, q0.y, q1.x, q1.y};
                    oT = __builtin_amdgcn_mfma_f32_16x16x32_bf16(__builtin_bit_cast(bf16x8, aw), __builtin_bit_cast(bf16x8, bw), oT, 0, 0, 0);
                    const bf16x8 ka = *(const LAS bf16x8*)(KT + c16 * HQ_P + 32 * s2 + 8 * g), qb = *(const LAS bf16x8*)(QT + c16 * HQ_P + 32 * s2 + 8 * g);
                    AT = __builtin_amdgcn_mfma_f32_16x16x32_bf16(ka, qb, AT, 0, 0, 0);
                }
#pragma unroll
                for (int i = 0; i < 4; ++i) AT[i] = (4 * g + i <= c16) ? AT[i] : 0.f;
                const u32x4 atw = (u32x4){cvtpk(AT[0], AT[1]), cvtpk(AT[2], AT[3]), 0u, 0u};
                const u32x2 vv = *(const LAS u32x2*)(VT + (16 * w + c16) * HK_P + 4 * g);
                const u32x4 vw = (u32x4){vv.x, vv.y, 0u, 0u};
                oT = __builtin_amdgcn_mfma_f32_16x16x32_bf16(__builtin_bit_cast(bf16x8, vw), __builtin_bit_cast(bf16x8, atw), oT, 0, 0, 0);
                *(LAS f32x4*)(OB + c16 * HO_P + 16 * w + 4 * g) = oT;
            }
            bf16x8 vb = zero8; if (g < 2) vb = *(const LAS bf16x8*)(VT + (16 * w + c16) * HK_P + 8 * g);
#pragma unroll
            for (int kt = 0; kt < 8; ++kt) {
                bf16x8 ka = zero8; if (g < 2) ka = *(const LAS bf16x8*)(KH + (16 * kt + c16) * HK_P + 8 * g);
                const f32x4 dd = *(const LAS f32x4*)(DD + 16 * kt + 4 * g);
                S[kt] = __builtin_amdgcn_mfma_f32_16x16x32_bf16(ka, vb, S[kt] * dd, 0, 0, 0);
            }
        }
        LDS_BAR();
        if (PASS3) {
            const int tt = tid >> 5, c4 = (tid & 31) * 4;
            const f32x4 o = *(const LAS f32x4*)(OB + tt * HO_P + c4);
            float ss = (o[0] * o[0] + o[1] * o[1]) + (o[2] * o[2] + o[3] * o[3]);
#pragma unroll
            for (int m = 1; m < 32; m <<= 1) ss += __shfl_xor(ss, m);
            const float rstd = rsqrtf(ss * (1.0f / 128.0f) + 1e-6f);
            const size_t row = (size_t)(t0 + blk * 16 + tt);
            u32x2 wv; wv.x = cvtpk(o[0] * rstd * gn[0] * bflo(gg.x), o[1] * rstd * gn[1] * bfhi(gg.x)); wv.y = cvtpk(o[2] * rstd * gn[2] * bflo(gg.y), o[3] * rstd * gn[3] * bfhi(gg.y));
            *(u32x2*)((bf16_t*)(a.ws + WS_MIX) + row * D + h * 128 + c4) = wv;
        }
    }
    if (!PASS3) {
        float* up = U + (size_t)(bh * NSPAN + j) * 16384 + (size_t)w * 2048 + lane * 4;
#pragma unroll
        for (int kt = 0; kt < 8; ++kt) *(f32x4*)(up + kt * 256) = S[kt];
        if (tq == 0) DU[(size_t)(bh * NSPAN + j) * 128 + pk] = __expf(bsum);
    } else if (j == NSPAN - 1) {
        float* hp = a.out + O_HP + ((size_t)(l * NBP + b) * 4 + h) * 16384 + 16 * w + c16;
#pragma unroll
        for (int kt = 0; kt < 8; ++kt)
#pragma unroll
            for (int i = 0; i < 4; ++i) hp[(size_t)(16 * kt + 4 * g + i) * 128] = S[kt][i];
    }
    __syncthreads();
}

__device__ __forceinline__ void hgrn_sample_unit(const Args& a, LAS unsigned char* lds, int l, int b, int h) {
    const int tid = TID(), v = tid & 127, kq = tid >> 7;
    LAS float* red = (LAS float*)lds;
    const size_t row = (size_t)(MP + b);
    const unsigned char* qb_ = (const unsigned char*)(a.ws + WS_QFK) + row * QFKB; const float* qF = (const float*)qb_ + h * 128; const bf16_t* qQ = (const bf16_t*)(qb_ + QFK_Q) + h * 128; const bf16_t* Z = (const bf16_t*)(a.ws + WS_Z) + row * ZC;
    const float vv = bf2f(Z[ZV + h * 128 + v]);
    const float* sp = INP(2) + (((size_t)l * MS + b) * 4 + h) * 16384 + (size_t)(kq * 32) * 128 + v;
    float* so = a.out + O_HS + (((size_t)l * MS + b) * 4 + h) * 16384 + (size_t)(kq * 32) * 128 + v;
    float o = 0.f;
    float sv[32];
#pragma unroll
    for (int i = 0; i < 32; ++i) sv[i] = __builtin_nontemporal_load(sp + (size_t)i * 128);
#pragma unroll
    for (int i = 0; i < 32; ++i) { const int k = kq * 32 + i; const float kk_ = qF[k]; const float s = (1.0f - kk_) * sv[i] + kk_ * vv; __builtin_nontemporal_store(s, so + (size_t)i * 128); o += bf2f(qQ[k]) * s; }
    __syncthreads();
    red[kq * 128 + v] = o;
    __syncthreads();
    if (tid < 128) {
        const float ot = (red[v] + red[128 + v]) + (red[256 + v] + red[384 + v]);
        float ss = wave_sum(ot * ot);
        red[512 + (tid >> 6)] = ss;
    }
    __syncthreads();
    if (tid < 128) {
        const float ot = (red[v] + red[128 + v]) + (red[256 + v] + red[384 + v]);
        const float rstd = rsqrtf((red[512] + red[513]) * (1.0f / 128.0f) + 1e-6f);
        const float val = ot * rstd * INP(10)[(size_t)l * 512 + h * 128 + v] * bf2f(Z[ZG + h * 128 + v]);
        ((bf16_t*)(a.ws + WS_MIX))[row * D + h * 128 + v] = (bf16_t)(cvt_pk_bf16(val, 0.f) & 0xffffu);
    }
    __syncthreads();
}

__device__ __forceinline__ void pool_phase(const Args& a, int l) {
    const int gt = blockIdx.x * 512 + TID(), NT = gridDim.x * 512;
    const bf16_t* Z = (const bf16_t*)(a.ws + WS_Z); bf16_t* MIX = (bf16_t*)(a.ws + WS_MIX);
    for (int it = gt; it < MP * 32; it += NT) {
        const int r = it >> 5, c8 = (it & 31) * 8, t = r & (SEQ - 1), wnd = 2 << (c8 >> 6);
        const int n = (t + 1 < wnd) ? t + 1 : wnd;
        float s[8];
#pragma unroll
        for (int q = 0; q < 8; ++q) s[q] = 0.f;
        u32x4 cur = *(const u32x4*)(Z + (size_t)r * ZC + ZP + c8);
        u32x4 pv[15];
#pragma unroll
        for (int i = 1; i < 16; ++i) pv[i - 1] = (i < n) ? *(const u32x4*)(Z + (size_t)(r - i) * ZC + ZP + c8) : (u32x4){0u, 0u, 0u, 0u};
#pragma unroll
        for (int i = 0; i < 15; ++i) { const u32x4 p = pv[i];
            s[0] += bflo(p.x); s[1] += bfhi(p.x); s[2] += bflo(p.y); s[3] += bfhi(p.y); s[4] += bflo(p.z); s[5] += bfhi(p.z); s[6] += bflo(p.w); s[7] += bfhi(p.w); }
        const float x[8] = {bflo(cur.x), bfhi(cur.x), bflo(cur.y), bfhi(cur.y), bflo(cur.z), bfhi(cur.z), bflo(cur.w), bfhi(cur.w)};
        const float inv = 1.0f / (float)n; float z[8];
#pragma unroll
        for (int q = 0; q < 8; ++q) z[q] = (s[q] + x[q]) * inv - x[q];
        u32x4 o; o.x = cvt_pk_bf16(z[0], z[1]); o.y = cvt_pk_bf16(z[2], z[3]); o.z = cvt_pk_bf16(z[4], z[5]); o.w = cvt_pk_bf16(z[6], z[7]);
        *(u32x4*)(MIX + (size_t)r * D + 512 + c8) = o;
    }
    for (int it = gt; it < MS * 256; it += NT) {
        const int b = it >> 8, c = it & 255, wnd = 2 << (c >> 6);
        const float* st = INP(3) + ((size_t)l * MS + b) * 15 * 256 + c;
        const float x = bf2f(Z[(size_t)(MP + b) * ZC + ZP + c]);
        float stv[15];
#pragma unroll
        for (int i = 0; i < 15; ++i) stv[i] = st[(size_t)i * 256];
        float s = x;
#pragma unroll
        for (int i = 1; i < 16; ++i) s += (i < wnd) ? stv[15 - i] : 0.f;
        const float z = s / (float)wnd - x;
        MIX[(size_t)(MP + b) * D + 512 + c] = (bf16_t)(cvt_pk_bf16(z, 0.f) & 0xffffu);
        float* ps = a.out + O_PS + ((size_t)l * MS + b) * 15 * 256 + c;
#pragma unroll
        for (int i = 0; i < 14; ++i) ps[(size_t)i * 256] = stv[i + 1];
        ps[(size_t)14 * 256] = x;
    }
    for (int it = gt; it < NBP * 15 * 256; it += NT) {
        const int b = it / (15 * 256), rem = it - b * 15 * 256, i = rem >> 8, c = rem & 255;
        a.out[O_PP + ((size_t)l * NBP + b) * 15 * 256 + rem] = bf2f(Z[(size_t)(b * SEQ + SEQ - 15 + i) * ZC + ZP + c]);
    }
}

constexpr int GV_P = 136;
__device__ __forceinline__ void gating_unit(const Args& a, LAS unsigned char* lds, int l, int unit) {
    const int tid = TID(), lane = tid & 63, w = __builtin_amdgcn_readfirstlane(tid >> 6), c16 = lane & 15, g4 = lane >> 4;
    const int g = unit & 3, ch = (unit >> 2) & 15, b = unit >> 6, r0 = b * SEQ + ch * 128;
    LAS bf16_t* vnT = (LAS bf16_t*)lds;
    const bf16_t* Z = (const bf16_t*)(a.ws + WS_Z); bf16_t* MIX = (bf16_t*)(a.ws + WS_MIX);
    const float* lg = INP(13) + l * 256, * lbb = INP(14) + l * 256;
    __syncthreads();
    {
        const int c = 4 * lane; const bool mine = (lane >> 4) == g;
        const f32x4 gg = *(const f32x4*)(lg + c), bb = *(const f32x4*)(lbb + c);
        u32x2 pall[16];
#pragma unroll
        for (int i = 0; i < 16; ++i) pall[i] = *(const u32x2*)(Z + (size_t)(r0 + 16 * w + i) * ZC + ZVC + c);
#pragma unroll
        for (int q = 0; q < 4; ++q) {
            u32x2 p[4];
#pragma unroll
            for (int i = 0; i < 4; ++i) p[i] = pall[4 * q + i];
            float x[4][4], sm[4];
#pragma unroll
            for (int i = 0; i < 4; ++i) { x[i][0] = bflo(p[i].x); x[i][1] = bfhi(p[i].x); x[i][2] = bflo(p[i].y); x[i][3] = bfhi(p[i].y); sm[i] = (x[i][0] + x[i][1]) + (x[i][2] + x[i][3]); }
#pragma unroll
            for (int o = 1; o < 64; o <<= 1) {
#pragma unroll
                for (int i = 0; i < 4; ++i) sm[i] += __shfl_xor(sm[i], o); }
            float sq[4];
#pragma unroll
            for (int i = 0; i < 4; ++i) { const float mu = sm[i] * (1.0f / 256.0f);
#pragma unroll
                for (int e = 0; e < 4; ++e) x[i][e] -= mu;
                sq[i] = (x[i][0] * x[i][0] + x[i][1] * x[i][1]) + (x[i][2] * x[i][2] + x[i][3] * x[i][3]); }
#pragma unroll
            for (int o = 1; o < 64; o <<= 1) {
#pragma unroll
                for (int i = 0; i < 4; ++i) sq[i] += __shfl_xor(sq[i], o); }
            if (mine) {
#pragma unroll
                for (int i = 0; i < 4; ++i) { const float rstd = rsqrtf(sq[i] * (1.0f / 256.0f) + 1e-6f); const int sidx = 16 * w + 4 * q + i;
#pragma unroll
                    for (int e = 0; e < 4; ++e) vnT[((c & 63) + e) * GV_P + sidx] = (bf16_t)(cvt_pk_bf16(x[i][e] * rstd * gg[e] + bb[e], 0.f) & 0xffffu); }
            }
        }
    }
    __syncthreads();
    {
        const bf16_t* Wb = (const bf16_t*)(a.ws + WS_CWS) + (size_t)(l * 4 + g) * 16384 + (size_t)(16 * w + c16) * 128 + 8 * g4;
        const int nks = (w >> 1) + 1;
        bf16x8 af[4];
#pragma unroll
        for (int ks = 0; ks < 4; ++ks) af[ks] = (ks < nks) ? *(const bf16x8*)(Wb + 32 * ks) : (bf16x8){0, 0, 0, 0, 0, 0, 0, 0};
        const float* bs = INP(16) + (size_t)(l * 4 + g) * 128 + 16 * w + 4 * g4;
        const f32x4 bsv = *(const f32x4*)bs;
        unsigned short uu_[4][4];
#pragma unroll
        for (int ct = 0; ct < 4; ++ct)
#pragma unroll
            for (int i = 0; i < 4; ++i) uu_[ct][i] = Z[(size_t)(r0 + 16 * w + 4 * g4 + i) * ZC + ZU + g * 64 + 16 * ct + c16];
#pragma unroll
        for (int ct = 0; ct < 4; ++ct) {
            f32x4 acc = (f32x4){0.f, 0.f, 0.f, 0.f};
#pragma unroll
            for (int ks = 0; ks < 4; ++ks) if (ks < nks) { const bf16x8 bf = *(const LAS bf16x8*)(vnT + (16 * ct + c16) * GV_P + 32 * ks + 8 * g4); acc = __builtin_amdgcn_mfma_f32_16x16x32_bf16(af[ks], bf, acc, 0, 0, 0); }
#pragma unroll
            for (int i = 0; i < 4; ++i) { const size_t row = (size_t)(r0 + 16 * w + 4 * g4 + i); const int cc = g * 64 + 16 * ct + c16;
                const float uu = bf2f(uu_[ct][i]);
                MIX[row * D + 768 + cc] = (bf16_t)(cvt_pk_bf16(uu * (acc[i] + bsv[i]), 0.f) & 0xffffu); }
        }
    }
}
__device__ __forceinline__ void gating_sample(const Args& a, int l) {
    const int tid_ = TID(), lane = tid_ & 63, gw = blockIdx.x * 8 + (tid_ >> 6), NGW = gridDim.x * 8;
    const bf16_t* Z = (const bf16_t*)(a.ws + WS_Z); bf16_t* MIX = (bf16_t*)(a.ws + WS_MIX);
    for (int b = gw; b < MS; b += NGW) {
        const size_t row = (size_t)(MP + b);
        const u32x2 p = *(const u32x2*)(Z + row * ZC + ZVC + 4 * lane);
        const float x0 = bflo(p.x), x1 = bfhi(p.x), x2 = bflo(p.y), x3 = bfhi(p.y);
        const float mu = wave_sum((x0 + x1) + (x2 + x3)) * (1.0f / 256.0f);
        const float d0 = x0 - mu, d1 = x1 - mu, d2 = x2 - mu, d3 = x3 - mu;
        const float rstd = rsqrtf(wave_sum((d0 * d0 + d1 * d1) + (d2 * d2 + d3 * d3)) * (1.0f / 256.0f) + 1e-6f);
        const int c = 4 * lane, g = lane >> 4;
        const f32x4 gg = *(const f32x4*)(INP(13) + l * 256 + c), bb = *(const f32x4*)(INP(14) + l * 256 + c);
        const f32x4 vn = (f32x4){d0 * rstd * gg[0] + bb[0], d1 * rstd * gg[1] + bb[1], d2 * rstd * gg[2] + bb[2], d3 * rstd * gg[3] + bb[3]};
        *(f32x4*)(a.out + O_CV + ((size_t)l * MS + b) * 256 + c) = vn;
        const float w00 = INP(15)[(size_t)(l * 4 + g) * 16384], b0 = INP(16)[(size_t)(l * 4 + g) * 128];
        const u32x2 up = *(const u32x2*)(Z + row * ZC + ZU + c);
        u32x2 o; o.x = cvt_pk_bf16(bflo(up.x) * (w00 * vn[0] + b0), bfhi(up.x) * (w00 * vn[1] + b0)); o.y = cvt_pk_bf16(bflo(up.y) * (w00 * vn[2] + b0), bfhi(up.y) * (w00 * vn[3] + b0));
        *(u32x2*)(MIX + row * D + 768 + c) = o;
    }
}

#define XB_TMO      128
#define XB_XCNT(j)  (256  + 64 * (j))
#define XB_XSUB(j)  (1280 + 64 * (j))
#define XB_XGEN(j)  (2304 + 64 * (j))
#define XB_TOP      3328
#define XB_TOPGEN   3392
#define XCD_BAR_WORDS 3456
#define XB_SPIN_CAP (1u << 18)

__device__ __forceinline__ unsigned xb_ld(unsigned* p)              { return __hip_atomic_load(p, __ATOMIC_RELAXED, __HIP_MEMORY_SCOPE_AGENT); }
__device__ __forceinline__ unsigned xb_add(unsigned* p, unsigned v) { return __hip_atomic_fetch_add(p, v, __ATOMIC_RELAXED, __HIP_MEMORY_SCOPE_AGENT); }
__device__ __forceinline__ unsigned xb_xcc_id() { return (unsigned)__builtin_amdgcn_s_getreg((3 << 11) | 20) & 0xFu; }
#define XB_SPIN(cond, bar) do { unsigned _sp = 0; while (cond) { __builtin_amdgcn_s_sleep(1); \
    if ((++_sp & 255u) == 0u) { if (xb_ld(&(bar)[XB_TMO])) break; if (_sp > XB_SPIN_CAP) { atomicAdd(&(bar)[XB_TMO], 1u); break; } } } } while (0)

struct XcdBarrier {
    unsigned* bar; unsigned x;
    volatile LAS unsigned* st;
};

__device__ __forceinline__ XcdBarrier xcd_barrier_post(unsigned* bar, volatile LAS unsigned* st) {
    XcdBarrier b; b.bar = bar; b.x = xb_xcc_id(); b.st = st;
    if (threadIdx.x == 0) (void)xb_add(&bar[XB_XCNT(b.x)], 1u);
    return b;
}
__device__ __forceinline__ void xcd_barrier_complete(unsigned* bar, unsigned x, unsigned& nloc, unsigned& nx) {
    const unsigned G = gridDim.x * gridDim.y * gridDim.z;
    unsigned sum, cnt, mine, sp = 0u;
    for (;;) {
        sum = 0u; cnt = 0u; mine = 0u;
#pragma unroll
        for (unsigned j = 0; j < 16; ++j) { const unsigned c = xb_ld(&bar[XB_XCNT(j)]); sum += c; cnt += (c > 0u) ? 1u : 0u; mine = (j == x) ? c : mine; }
        if (sum == G) break;
        __builtin_amdgcn_s_sleep(1);
        if ((++sp & 255u) == 0u) { if (xb_ld(&bar[XB_TMO])) break; if (sp > XB_SPIN_CAP) { atomicAdd(&bar[XB_TMO], 1u); break; } }
    }
    nloc = mine > 0u ? mine : 1u; nx = cnt > 0u ? cnt : 1u;
}

__device__ __forceinline__ void xcd_barrier(const XcdBarrier& b) {
    asm volatile("s_waitcnt vmcnt(0)" ::: "memory");
    __syncthreads();
    if (threadIdx.x == 0) {
        unsigned* bar = b.bar;
        __builtin_amdgcn_s_waitcnt(0);
        unsigned nloc = b.st[0], nx = b.st[1];
        if (nloc == 0u) { xcd_barrier_complete(bar, b.x, nloc, nx); b.st[0] = nloc; b.st[1] = nx; }
        const unsigned old = xb_add(&bar[XB_XSUB(b.x)], 1u);
        const unsigned gen = old / nloc;
        if (old + 1u == (gen + 1u) * nloc) {
            __builtin_amdgcn_fence(__ATOMIC_RELEASE, "agent");
            asm volatile("s_waitcnt vmcnt(0)" ::: "memory");
            const unsigned og = xb_add(&bar[XB_TOP], 1u);
            const unsigned tg = og / nx;
            if (og + 1u == (tg + 1u) * nx) xb_add(&bar[XB_TOPGEN], 1u);
            else XB_SPIN(xb_ld(&bar[XB_TOPGEN]) == tg, bar);
            __builtin_amdgcn_fence(__ATOMIC_ACQUIRE, "agent");
            xb_add(&bar[XB_XGEN(b.x)], 1u);
            asm volatile("s_waitcnt vmcnt(0)" ::: "memory");
        } else {
            XB_SPIN(xb_ld(&bar[XB_XGEN(b.x)]) == gen, bar);
            __builtin_amdgcn_fence(__ATOMIC_ACQUIRE, "agent");
            asm volatile("s_waitcnt vmcnt(0)" ::: "memory");
        }
    }
    __syncthreads();
}

constexpr int NSUB = 10;
constexpr int N_PHASES = 2 + NSUB * DEPTH + 1;
#ifndef ENMASK
#define ENMASK 0xffff
#endif
#define EN(k) (((ENMASK) >> (k)) & 1)
__global__ void __launch_bounds__(512, 2) fwd_kernel(Args a) {
    extern __shared__ __attribute__((aligned(16))) unsigned char lds_raw[];
    LAS unsigned char* lds = (LAS unsigned char*)lds_raw;
    cg::grid_group grid = cg::this_grid();
    if (threadIdx.x == 0) { LAS unsigned long long* tb = (LAS unsigned long long*)(lds + PTR_TBL_OFF);
#define PT_(k) tb[k] = (unsigned long long)a.in[k];
        PT_(0) PT_(1) PT_(2) PT_(3) PT_(4) PT_(5) PT_(6) PT_(7) PT_(8) PT_(9) PT_(10) PT_(11) PT_(12) PT_(13) PT_(14) PT_(15) PT_(16) PT_(17) PT_(18) PT_(19) PT_(20) PT_(21) PT_(22) PT_(23)
#undef PT_
    }
    volatile LAS unsigned* bst = (volatile LAS unsigned*)(lds + 131072 + 512);
    if (threadIdx.x < 2) bst[threadIdx.x] = 0u;
    __syncthreads();
    XcdBarrier xbar = xcd_barrier_post((unsigned*)(a.ws + WS_CTL), bst);
#if defined(REPMASK)
    int rep_ = 0;
#endif
    for (int ph = a.ph_lo; ph < a.ph_hi; ++ph) {
        unsigned char* ws = a.ws; int G = gridDim.x, bx = blockIdx.x;
        asm volatile("" : "+s"(ws), "+s"(G), "+s"(bx));
#if defined(REPMASK)
        const int s__ = (ph - 2) % NSUB; const int ty_ = ph == 0 ? 0 : ph == 1 ? 1 : ph == N_PHASES - 1 ? 2 : (s__ == 0 || s__ == 7) ? 3 : (s__ == 1 || s__ == 4) ? 4 : s__ == 2 ? 5 : s__ == 3 ? 6 : s__ == 5 ? 7 : s__ == 8 ? 9 : 8;
#endif
        if (ph == 0) { if (EN(0)) prologue(a, lds, 0, 0, 0, 0); }
        else if (ph == 1 && EN(1)) {
            const int nG = G < 96 ? G : 96, nF = G - nG; const bool gm = bx >= nF; const int wv_ = __builtin_amdgcn_readfirstlane(TID() >> 6);
            if (gm) {
                pg8::Gemm g{(const bf16_t*)(ws + WS_COND), (const bf16_t*)(ws + WS_WADA), D, D}; pg8::Order<1> S; S.init(1, NMOD / 256, nG, bx - nF, 0, D / 64);
                pg8::EpiAda E{(float*)(ws + WS_MOD), INP(7)};
                pg8::gemm_phase<pg8::EpiAda, true, 1>(lds, g, S, E);
                __syncthreads();
            }
            const int tsl = nF * 8 * 3 + nG * 8 * 2;
            prologue(a, lds, 1, gm ? nF * 24 + ((bx - nF) * 8 + wv_) * 2 : (bx * 8 + wv_) * 3, gm ? 2 : 3, tsl);
        } else if (ph == N_PHASES - 1) { if (EN(2)) final_phase(a); }
        else if (ph == 1) {}
        else {
            const int l = (ph - 2) / NSUB, s = (ph - 2) % NSUB;
            if (s == 0) { if (EN(3)) norm_phase(a, l, 0, l == 0); }
            else if ((s == 1 || s == 4) && EN(4)) {
                pg8::Gemm g{(const bf16_t*)(ws + WS_H), (const bf16_t*)(ws + WS_WIN) + (size_t)l * INC * D, D, D}; pg8::Order<1> S;
                if (s == 1) S.init(MP / 256, 11, G, bx, INC / 256, D / 64); else { S.init(MP / 256, 12, G, bx, 0, D / 64); S.pofs = 11; }
                pg8::EpiIn E{(float*)(ws + WS_QFK), (bf16_t*)(ws + WS_Z), (const float*)(ws + WS_LB) + l * 512};
                pg8::gemm_phase<pg8::EpiIn, true, 1>(lds, g, S, E);
            } else if (s == 2 && EN(5)) {
#ifndef REPA
#define REPA 0
#endif
                for (int rp = 0; rp <= ((REPA >> 0) & 1); ++rp)
                for (int u = bx; u < NBP * 4 * (NSPAN - 1); u += G) { const int bh = u / (NSPAN - 1), j = u % (NSPAN - 1); hgrn_unit<false>(a, lds, l, bh >> 2, bh & 3, j); }
                for (int rp = 0; rp <= ((REPA >> 1) & 1); ++rp)
                pool_phase(a, l);
                for (int rp = 0; rp <= ((REPA >> 2) & 1); ++rp)
                for (int u = G - 1 - bx; u < NBP * 16 * 4; u += G) gating_unit(a, lds, l, u);
                gating_sample(a, l);
                __syncthreads();
                for (int rp = 0; rp <= ((REPA >> 3) & 1); ++rp)
                for (int u = G - 1 - bx; u < MS * 4; u += G) hgrn_sample_unit(a, lds, l, u >> 2, u & 3);
            } else if (s == 3 && EN(6)) {
                for (int u = bx; u < NBP * 4 * NSPAN; u += G) { const int bh = u >> 3, j = u & 7; hgrn_unit<true>(a, lds, l, bh >> 2, bh & 3, j); }
            } else if (s == 5 && EN(7)) {
                pg8::Gemm g{(const bf16_t*)(ws + WS_MIX), (const bf16_t*)(ws + WS_WBR) + (size_t)l * D * D, D, D}; pg8::Order<1> S; S.init(MP / 256, D / 256, G, bx, 0, D / 64);
                bf16_t* Mb = (bf16_t*)(ws + WS_H); const bf16_t* Z = (const bf16_t*)(ws + WS_Z);
                pg8::EpiBranch E{Mb, Z};
                pg8::gemm_phase<pg8::EpiBranch, true, 1>(lds, g, S, E);
                sample_gemm_branch(lds, g.A + (size_t)MP * D, g.Bt, Mb, Z);
            } else if ((s == 6 || s == 9) && EN(8)) {
                const bool ff = (s == 9);
                const float* Gm = (const float*)(ws + WS_MOD) + l * NADA + (ff ? 5 : 2) * D;
                pg8::Gemm g; if (ff) g = pg8::Gemm{(const bf16_t*)(ws + WS_Z), (const bf16_t*)(ws + WS_WFO) + (size_t)l * D * FF, FF, FF}; else g = pg8::Gemm{(const bf16_t*)(ws + WS_H), (const bf16_t*)(ws + WS_WOUT) + (size_t)l * D * D, D, D};
                pg8::Order<1> S; S.init(MP / 256, D / 256, G, bx, 0, ff ? FF / 64 : D / 64);
                const bool src_in = (!ff && l == 0);
                pg8::EpiRes E{a.out, Gm, src_in ? INP(0) : a.out};
                pg8::gemm_phase<pg8::EpiRes, true, 1>(lds, g, S, E);
                SampEpiRes epi{a.out, Gm, src_in ? INP(1) : a.out + (size_t)MP * D};
                sample_gemm(lds, g.A + (size_t)MP * g.lda, g.lda, g.Bt, g.ldb, 0, ff ? FF : D, epi);
            } else if (s == 7) { if (EN(3)) norm_phase(a, l, 1, false); }
            else if (s == 8 && EN(9)) {
                pg8::Gemm g{(const bf16_t*)(ws + WS_H), (const bf16_t*)(ws + WS_WFI) + (size_t)l * 2 * FF * D, D, D}; pg8::Order<1> S; S.init(MP / 256, 2 * FF / 256, G, bx, 2 * FF / 256, D / 64);
                pg8::EpiFfn E{(bf16_t*)(ws + WS_Z)};
                pg8::gemm_phase<pg8::EpiFfn, true, 1>(lds, g, S, E);
            }
        }
        if (ph >= 2 && (ph - 2) % NSUB == 3) continue;
        if (ph + 1 < a.ph_hi) { if (ph == 0) grid.sync(); else xcd_barrier(xbar); }
#if defined(REPMASK)
        if (((REPMASK) >> ty_) & 1) { if (!rep_) { rep_ = 1; --ph; } else rep_ = 0; }
#endif
    }
}

#ifndef ONE_LAUNCH
#define ONE_LAUNCH 1
#endif
extern "C" void kernel_launch(void* const* d_in, const int* in_sizes, int n_in, void* d_out, int out_size, void* d_ws, size_t ws_size, hipStream_t stream) {
    static int grid = 0;
    if (grid == 0) {
        if (n_in != 24 || ws_size < WS_END) { fprintf(stderr, "kernel_launch: unexpected n_in %d or ws_size %zu (< %zu)\n", n_in, ws_size, (size_t)WS_END); grid = -1; return; }
        int dev = 0, cus = 0, per_cu = 0;
        hipGetDevice(&dev); hipDeviceGetAttribute(&cus, hipDeviceAttributeMultiprocessorCount, dev);
        if (hipFuncSetAttribute((const void*)fwd_kernel, hipFuncAttributeMaxDynamicSharedMemorySize, LDS_BYTES) != hipSuccess) { fprintf(stderr, "kernel_launch: hipFuncSetAttribute failed\n"); grid = -1; return; }
        if (hipOccupancyMaxActiveBlocksPerMultiprocessor(&per_cu, (const void*)fwd_kernel, 512, LDS_BYTES) != hipSuccess || per_cu < 1) { fprintf(stderr, "kernel_launch: occupancy query failed (%d)\n", per_cu); (void)hipGetLastError(); per_cu = 1; }
        grid = cus * (per_cu > 1 ? 1 : per_cu);
        fprintf(stderr, "kernel_launch: grid %d (cus %d, per_cu %d)\n", grid, cus, per_cu);
    }
    if (grid < 0) return;
    if (hipMemsetAsync((char*)d_ws + WS_CTL, 0, CTL_BYTES, stream) != hipSuccess) { fprintf(stderr, "kernel_launch: memset failed\n"); return; }
    Args a{};
    for (int i = 0; i < 24; ++i) a.in[i] = (const float*)d_in[i];
    a.out = (float*)d_out; a.ws = (unsigned char*)d_ws;
#if ONE_LAUNCH
    a.ph_lo = 0; a.ph_hi = N_PHASES;
    void* args[] = {&a};
    hipError_t e = hipLaunchCooperativeKernel((const void*)fwd_kernel, dim3(grid), dim3(512), args, LDS_BYTES, stream);
    if (e != hipSuccess) fprintf(stderr, "cooperative launch failed: %s (grid %d)\n", hipGetErrorString(e), grid);
#else
    for (int ph = 0; ph < N_PHASES; ++ph) {
        a.ph_lo = ph; a.ph_hi = ph + 1;
        hipLaunchKernelGGL(fwd_kernel, dim3(grid), dim3(512), LDS_BYTES, stream, a);
    }
#endif
}
```
